# Optimizing an MI355X kernel written in HIP

```python
import jax, jax.numpy as jnp
from jax import lax
import numpy as np

D_MODEL = 1024
BATCH = 8
SEQ = 4096
DEPTH = 1

HEAD_DIM = 64
ROT_DIM = HEAD_DIM // 4
ROPE_THETA = 500000.0
ATTN_SCALE = HEAD_DIM ** -0.5
QBLOCK = 128

A_HEADS = 12
A_WIDTH = A_HEADS * HEAD_DIM
IDX_HEADS = 8
IDX_DIM = 64
IDX_SCALE = (IDX_HEADS ** -0.5) * (IDX_DIM ** -0.5)
TOPK_MAX = 256

B_GROUPS = ((128, 1), (512, 4), (2048, 16))
B_HEADS_PER_GROUP = 4
B_HEADS = B_HEADS_PER_GROUP * len(B_GROUPS)
B_WIDTH = B_HEADS * HEAD_DIM
B_OUT_WIDTH = B_HEADS_PER_GROUP * HEAD_DIM

FFN_HIDDEN = -(-8 * D_MODEL // (3 * 256)) * 256

DN_ALPHA = (2 * DEPTH) ** 0.25
DN_BETA = (8 * DEPTH) ** -0.25
LN_EPS = 1e-5
NEG = -1e30

IN_SPLITS = (A_WIDTH, A_WIDTH, A_WIDTH, B_WIDTH, B_WIDTH, B_WIDTH,
             IDX_HEADS * IDX_DIM, IDX_DIM, IDX_HEADS, 2 * D_MODEL)
N_IN = sum(IN_SPLITS)

kernel_name = 'hybrid_dsa_dilated_gated_deepnorm'


def layer_norm(x, g, b):
    xf = x.astype(jnp.float32)
    mu = xf.mean(-1, keepdims=True)
    var = jnp.square(xf - mu).mean(-1, keepdims=True)
    y = (xf - mu) * lax.rsqrt(var + LN_EPS)
    return (y * g.astype(jnp.float32) + b.astype(jnp.float32)).astype(x.dtype)


def rope_tables(positions, dtype):
    inv_freq = ROPE_THETA ** (-jnp.arange(0, ROT_DIM, 2, dtype=jnp.float32) / ROT_DIM)
    ang = positions.astype(jnp.float32)[..., None] * inv_freq
    return (jnp.cos(ang).astype(dtype)[:, :, None, :],
            jnp.sin(ang).astype(dtype)[:, :, None, :])


def partial_rope(x, cos, sin):
    r = cos.shape[-1]
    x1, x2, rest = x[..., :r], x[..., r:2 * r], x[..., 2 * r:]
    return jnp.concatenate([x1 * cos - x2 * sin, x2 * cos + x1 * sin, rest], axis=-1)


def to_blocks(a):
    b, s = a.shape[:2]
    a = a.reshape((b, s // QBLOCK, QBLOCK) + a.shape[2:])
    return jnp.moveaxis(a, 1, 0)


def from_blocks(a):
    a = jnp.moveaxis(a, 0, 1)
    return a.reshape((a.shape[0], -1) + a.shape[3:])


def dsa_attention(q, k, v, q_idx, k_idx, w_idx):
    seq = q.shape[1]
    k_top = min(TOPK_MAX, seq // 4)
    nblk = seq // QBLOCK
    key_pos = jnp.arange(seq)
    k_idx_f = k_idx.astype(jnp.float32)

    def block(args):
        qb, qib, wb, start = args
        t = start + jnp.arange(QBLOCK)
        s = jnp.einsum('bqhd,bsd->bqhs', qib.astype(jnp.float32), k_idx_f)
        scores = jnp.einsum('bqh,bqhs->bqs', wb.astype(jnp.float32) * IDX_SCALE, jax.nn.relu(s))
        causal = key_pos[None, :] <= t[:, None]
        scores = jnp.where(causal[None], scores, NEG)
        _, sel = lax.top_k(scores, k_top)
        valid = sel <= t[None, :, None]
        gather = jax.vmap(lambda kv, ii: kv[ii])
        k_sel = gather(k, sel)
        v_sel = gather(v, sel)
        logits = jnp.einsum('bqhd,bqkhd->bhqk', qb, k_sel).astype(jnp.float32) * ATTN_SCALE
        logits = jnp.where(valid[:, None], logits, NEG)
        p = jax.nn.softmax(logits, axis=-1).astype(v.dtype)
        return jnp.einsum('bhqk,bqkhd->bqhd', p, v_sel)

    starts = jnp.arange(nblk, dtype=jnp.int32) * QBLOCK
    out = lax.map(block, (to_blocks(q), to_blocks(q_idx), to_blocks(w_idx), starts))
    return from_blocks(out)


def dilated_attention(q, k, v):
    seq = q.shape[1]
    nblk = seq // QBLOCK
    hs = [slice(g * B_HEADS_PER_GROUP, (g + 1) * B_HEADS_PER_GROUP) for g in range(len(B_GROUPS))]
    k_groups = [k[:, :, h] for h in hs]
    v_groups = [v[:, :, h] for h in hs]

    def block(args):
        qb, start = args
        t = start + jnp.arange(QBLOCK)
        outs, lses = [], []
        for g, (window, dil) in enumerate(B_GROUPS):
            offs = dil * jnp.arange(window // dil + 1)
            pos = t[:, None] - offs[None, :]
            valid = pos >= 0
            pos = jnp.maximum(pos, 0)
            k_g = k_groups[g][:, pos]
            v_g = v_groups[g][:, pos]
            logits = jnp.einsum('bqhd,bqjhd->bhqj', qb[:, :, hs[g]], k_g).astype(jnp.float32) * ATTN_SCALE
            logits = jnp.where(valid[None, None], logits, NEG)
            lse = jax.nn.logsumexp(logits, axis=-1)
            p = jnp.exp(logits - lse[..., None]).astype(v.dtype)
            outs.append(jnp.einsum('bhqj,bqjhd->bqhd', p, v_g))
            lses.append(lse)
        alpha = jax.nn.softmax(jnp.stack(lses, axis=0), axis=0)
        alpha = jnp.swapaxes(alpha, 2, 3)[..., None].astype(v.dtype)
        return jnp.sum(alpha * jnp.stack(outs, axis=0), axis=0)

    starts = jnp.arange(nblk, dtype=jnp.int32) * QBLOCK
    out = lax.map(block, (to_blocks(q), starts))
    return from_blocks(out)


def hybrid_layer(x, cos, sin, w_in, b_gate, w_branch_a, w_branch_b, w_out, ln1_g, ln1_b,
                 w_ffn_gate, w_ffn_up, w_ffn_down, ln2_g, ln2_b):
    bsz, seq, _ = x.shape
    points = np.cumsum(IN_SPLITS)[:-1].tolist()
    qa, ka, va, qb, kb, vb, qi, ki, wi, gate_pre = jnp.split(x @ w_in, points, axis=-1)
    heads = lambda a, h: a.reshape(bsz, seq, h, -1)
    qa = partial_rope(heads(qa, A_HEADS), cos, sin)
    ka = partial_rope(heads(ka, A_HEADS), cos, sin)
    qi = partial_rope(heads(qi, IDX_HEADS), cos, sin)
    ki = partial_rope(ki.reshape(bsz, seq, 1, IDX_DIM), cos, sin)[:, :, 0]
    o_a = dsa_attention(qa, ka, heads(va, A_HEADS), qi, ki, wi).reshape(bsz, seq, A_WIDTH)
    qb = partial_rope(heads(qb, B_HEADS), cos, sin)
    kb = partial_rope(heads(kb, B_HEADS), cos, sin)
    o_b = dilated_attention(qb, kb, heads(vb, B_HEADS)).reshape(bsz, seq, B_OUT_WIDTH)
    g_a, g_b = jnp.split(jax.nn.sigmoid(gate_pre + b_gate), 2, axis=-1)
    mixed = (g_a * (o_a @ w_branch_a) + g_b * (o_b @ w_branch_b)) @ w_out
    x = layer_norm(DN_ALPHA * x + mixed, ln1_g, ln1_b)
    h = jax.nn.silu(x @ w_ffn_gate) * (x @ w_ffn_up)
    return layer_norm(DN_ALPHA * x + h @ w_ffn_down, ln2_g, ln2_b)


def setup_inputs(seed: int = 0) -> dict:
    key = jax.random.key(seed)
    ks = jax.random.split(key, 16)
    nrm = lambda k, shape, scale: jax.random.normal(k, shape, jnp.float32) * scale
    return {
        'x': nrm(ks[0], (BATCH, SEQ, D_MODEL), 1.0),
        'positions': jnp.broadcast_to(jnp.arange(SEQ, dtype=jnp.int32), (BATCH, SEQ)),
        'w_in': nrm(ks[1], (DEPTH, D_MODEL, N_IN), D_MODEL ** -0.5),
        'b_gate': nrm(ks[2], (DEPTH, 2 * D_MODEL), 0.02),
        'w_branch_a': nrm(ks[3], (DEPTH, A_WIDTH, D_MODEL), A_WIDTH ** -0.5),
        'w_branch_b': nrm(ks[4], (DEPTH, B_OUT_WIDTH, D_MODEL), B_OUT_WIDTH ** -0.5),
        'w_out': nrm(ks[5], (DEPTH, D_MODEL, D_MODEL), DN_BETA * D_MODEL ** -0.5),
        'ln1_g': 1.0 + nrm(ks[6], (DEPTH, D_MODEL), 0.02),
        'ln1_b': nrm(ks[7], (DEPTH, D_MODEL), 0.02),
        'w_ffn_gate': nrm(ks[8], (DEPTH, D_MODEL, FFN_HIDDEN), D_MODEL ** -0.5),
        'w_ffn_up': nrm(ks[9], (DEPTH, D_MODEL, FFN_HIDDEN), D_MODEL ** -0.5),
        'w_ffn_down': nrm(ks[10], (DEPTH, FFN_HIDDEN, D_MODEL), DN_BETA * FFN_HIDDEN ** -0.5),
        'ln2_g': 1.0 + nrm(ks[11], (DEPTH, D_MODEL), 0.02),
        'ln2_b': nrm(ks[12], (DEPTH, D_MODEL), 0.02),
    }


def reference(x, positions, w_in, b_gate, w_branch_a, w_branch_b, w_out, ln1_g, ln1_b,
              w_ffn_gate, w_ffn_up, w_ffn_down, ln2_g, ln2_b):
    cos, sin = rope_tables(positions, x.dtype)
    for layer in range(DEPTH):
        x = hybrid_layer(x, cos, sin, w_in[layer], b_gate[layer], w_branch_a[layer],
                         w_branch_b[layer], w_out[layer], ln1_g[layer], ln1_b[layer],
                         w_ffn_gate[layer], w_ffn_up[layer], w_ffn_down[layer],
                         ln2_g[layer], ln2_b[layer])
    return x
```

```cpp
#include <hip/hip_runtime.h>
#include <hip/hip_cooperative_groups.h>
#include <cstdio>
#include <cstdint>
namespace cg = cooperative_groups;
#ifndef MK_N_LAUNCHES
#define MK_N_LAUNCHES 1
#endif
constexpr float C2 = 0.125f * 1.4426950408889634f;
constexpr float DN_ALPHA = 1.1892071150027210f;
namespace pg8 {
#define PG8_LAS __attribute__((address_space(3)))
typedef unsigned short bf16_t;
typedef short bf16x8 __attribute__((ext_vector_type(8)));
typedef float f32x4 __attribute__((ext_vector_type(4)));
typedef unsigned u32x4 __attribute__((ext_vector_type(4)));
constexpr int BM = 256, BK = 64, HALF = 128, HTB = HALF * BK * 2  , STAGE_BYTES = 8 * HTB, NXCD = 8, WGM = 8;

__host__ __device__ __forceinline__ int lds_byte(int r, int c) { const int st = (r >> 4) * 2 + (c >> 5), rr = r & 15, cc = c & 31, ob = rr * 64 + cc * 2; return st * 1024 + (ob ^ (((ob >> 9) & 1) << 5)); }
__host__ __device__ __forceinline__ void stage_rc(int b, int& R, int& C) { const int st = b / 1024, sb = b % 1024, swz = sb ^ (((sb >> 9) & 1) << 5); R = (st >> 1) * 16 + swz / 64; C = (st & 1) * 32 + (swz % 64) / 2; }
__host__ __device__ __forceinline__ int perm32(int rho) { const int n = rho >> 4, i = rho & 15; return 8 * (i >> 2) + 4 * n + (i & 3); }

struct Unit { int pm, pn; };
struct Gemm { const bf16_t* A; const bf16_t* Bt; int M, N, K; };

struct StaticOrder {
    int nM, nN, nwg, G, c;
    __host__ __device__ void init(int M, int N, int G_, int c_) { nM = M / BM; nN = N / BM; nwg = nM * nN; G = G_; c = c_; }
    __host__ __device__ bool next(int i, Unit& u) const {
        const long L = (long)i * G + c; if (L >= nwg) return false;
        int wgid = (int)L; { const int q = nwg / NXCD, r = nwg % NXCD, xcd = wgid % NXCD, off = wgid / NXCD; wgid = (xcd < r ? xcd * (q + 1) : r * (q + 1) + (xcd - r) * q) + off; }
        const int nig = WGM * nN, gid = wgid / nig, fm = gid * WGM, gsz = (nM - fm) < WGM ? (nM - fm) : WGM;
        u.pm = fm + ((wgid % nig) % gsz); u.pn = (wgid % nig) / gsz; return true;
    }
    __device__ __forceinline__ void a_ready(const Unit&) const {}
    __device__ __forceinline__ void done(const Unit&) const {}
};

typedef float f32x2_cv __attribute__((ext_vector_type(2))); typedef __bf16 bf16x2_cv __attribute__((ext_vector_type(2)));
__device__ __forceinline__ unsigned cvt_pk_bf16(float lo, float hi) { f32x2_cv v = {lo, hi}; bf16x2_cv b = __builtin_convertvector(v, bf16x2_cv); return __builtin_bit_cast(unsigned, b); }
__device__ __forceinline__ u32x4 pack8(f32x4 a, f32x4 b) { u32x4 w; w.x = cvt_pk_bf16(a[0], a[1]); w.y = cvt_pk_bf16(a[2], a[3]); w.z = cvt_pk_bf16(b[0], b[1]); w.w = cvt_pk_bf16(b[2], b[3]); return w; }
__device__ __forceinline__ void unpack8(u32x4 w, f32x4& a, f32x4& b) {
    a[0] = __uint_as_float(w.x << 16); a[1] = __uint_as_float(w.x & 0xffff0000u); a[2] = __uint_as_float(w.y << 16); a[3] = __uint_as_float(w.y & 0xffff0000u);
    b[0] = __uint_as_float(w.z << 16); b[1] = __uint_as_float(w.z & 0xffff0000u); b[2] = __uint_as_float(w.w << 16); b[3] = __uint_as_float(w.w & 0xffff0000u); }
#define EPI_LOOP_AM _Pragma("unroll") for (int ai = 0; ai < 2; ++ai) _Pragma("unroll") for (int m = 0; m < 4; ++m)
#define EPI_ROW (u.pm * BM + ai * HALF + wr * 64 + m * 16 + fr)
#define EPI_COL(bj) (u.pn * BM + (bj) * HALF + wc * 32 + 8 * fq)

struct EpiBf16 { static constexpr bool PERM = true, AFTER_DRAIN = false; bf16_t* O0; bf16_t* O1; int ldc;
    __device__ __forceinline__ void operator()(const f32x4 (&acc)[2][2][4][2], const Unit& u, int wr, int wc, int fr, int fq) const {
        bf16_t* O = u.pm < 3 ? O0 : O1 - (size_t)768 * ldc;
        EPI_LOOP_AM { const size_t row = EPI_ROW;
#pragma unroll
            for (int bj = 0; bj < 2; ++bj) *(u32x4*)(O + row * ldc + EPI_COL(bj)) = pack8(acc[ai][bj][m][0], acc[ai][bj][m][1]); } }
};
struct EpiProj { static constexpr bool PERM = true, AFTER_DRAIN = false;
    bf16_t *QA, *KA, *QB, *KB, *QI, *KIWI; const float* cs;
    __device__ __forceinline__ void operator()(const f32x4 (&acc)[2][2][4][2], const Unit& u, int wr, int wc, int fr, int fq) const {
        const int pn = u.pn; bf16_t* dst; int ldc, colt; float sc = 1.f;
        if (pn < 3) { dst = QA; ldc = 768; colt = 256 * pn; sc = C2; } else if (pn < 6) { dst = KA; ldc = 768; colt = 256 * (pn - 3); }
        else if (pn < 9) { dst = QB; ldc = 768; colt = 256 * (pn - 6); sc = C2; } else if (pn < 12) { dst = KB; ldc = 768; colt = 256 * (pn - 9); }
        else if (pn < 14) { dst = QI; ldc = 512; colt = 256 * (pn - 12); } else { dst = KIWI; ldc = 128; colt = 0; }
        const bool last = pn == 14, ropeLane = ((wc & 1) == 0) && fq < 2; const float sgn = fq == 0 ? -1.f : 1.f;
        EPI_LOOP_AM { const size_t row = EPI_ROW;
            f32x4 c0 = {0, 0, 0, 0}, c1 = c0, s0 = c0, s1 = c0;
            if (ropeLane) { const f32x4* p = (const f32x4*)(cs + row * 16); c0 = p[0]; c1 = p[1]; s0 = p[2]; s1 = p[3]; }
#pragma unroll
            for (int bj = 0; bj < 2; ++bj) { f32x4 v0 = acc[ai][bj][m][0], v1 = acc[ai][bj][m][1], p0, p1;
#pragma unroll
                for (int k = 0; k < 4; ++k) { p0[k] = __shfl_xor(v0[k], 16); p1[k] = __shfl_xor(v1[k], 16); }
                const bool doRope = ropeLane && (!last || (bj == 0 && wc == 0));
                if (doRope) { v0 = v0 * c0 + (sgn * p0) * s0; v1 = v1 * c1 + (sgn * p1) * s1; }
                v0 = v0 * sc; v1 = v1 * sc;
                if (!last || bj == 0) *(u32x4*)(dst + row * ldc + colt + bj * HALF + wc * 32 + 8 * fq) = pack8(v0, v1); } } }
};
struct EpiGate { static constexpr bool PERM = true, AFTER_DRAIN = false; bf16_t* O; int ldc; const float* bias;
    __device__ __forceinline__ void operator()(const f32x4 (&acc)[2][2][4][2], const Unit& u, int wr, int wc, int fr, int fq) const {
        f32x4 bv[2][2];
#pragma unroll
        for (int bj = 0; bj < 2; ++bj) { bv[bj][0] = *(const f32x4*)(bias + EPI_COL(bj)); bv[bj][1] = *(const f32x4*)(bias + EPI_COL(bj) + 4); }
        EPI_LOOP_AM { const size_t row = EPI_ROW;
#pragma unroll
            for (int bj = 0; bj < 2; ++bj) { f32x4 v[2];
#pragma unroll
                for (int n = 0; n < 2; ++n) { const f32x4 x = acc[ai][bj][m][n] + bv[bj][n];
#pragma unroll
                    for (int k = 0; k < 4; ++k) v[n][k] = __builtin_amdgcn_rcpf(1.f + __expf(-x[k])); }
                *(u32x4*)(O + row * ldc + EPI_COL(bj)) = pack8(v[0], v[1]); } } }
};
struct EpiBrA { static constexpr bool PERM = true, AFTER_DRAIN = false; float* T; const bf16_t* G;
    __device__ __forceinline__ void operator()(const f32x4 (&acc)[2][2][4][2], const Unit& u, int wr, int wc, int fr, int fq) const {
        EPI_LOOP_AM { const size_t row = EPI_ROW;
#pragma unroll
            for (int bj = 0; bj < 2; ++bj) { const int col = EPI_COL(bj); f32x4 g0, g1; unpack8(*(const u32x4*)(G + row * 2048 + col), g0, g1);
                *(f32x4*)(T + row * 1024 + col) = g0 * acc[ai][bj][m][0]; *(f32x4*)(T + row * 1024 + col + 4) = g1 * acc[ai][bj][m][1]; } } }
};
struct EpiBrB { static constexpr bool PERM = true, AFTER_DRAIN = false; const float* T; const bf16_t* G; bf16_t* O;
    __device__ __forceinline__ void operator()(const f32x4 (&acc)[2][2][4][2], const Unit& u, int wr, int wc, int fr, int fq) const {
        EPI_LOOP_AM { const size_t row = EPI_ROW;
#pragma unroll
            for (int bj = 0; bj < 2; ++bj) { const int col = EPI_COL(bj); f32x4 g0, g1; unpack8(*(const u32x4*)(G + row * 2048 + 1024 + col), g0, g1);
                const f32x4 t0 = *(const f32x4*)(T + row * 1024 + col), t1 = *(const f32x4*)(T + row * 1024 + col + 4);
                *(u32x4*)(O + row * 1024 + col) = pack8(t0 + g0 * acc[ai][bj][m][0], t1 + g1 * acc[ai][bj][m][1]); } } }
};
struct EpiRes { static constexpr bool PERM = true, AFTER_DRAIN = false; const float* R; float* Z;
    __device__ __forceinline__ void operator()(const f32x4 (&acc)[2][2][4][2], const Unit& u, int wr, int wc, int fr, int fq) const {
        EPI_LOOP_AM { const size_t row = EPI_ROW;
#pragma unroll
            for (int bj = 0; bj < 2; ++bj) { const int col = EPI_COL(bj);
                const f32x4 r0 = *(const f32x4*)(R + row * 1024 + col), r1 = *(const f32x4*)(R + row * 1024 + col + 4);
                *(f32x4*)(Z + row * 1024 + col) = r0 * DN_ALPHA + acc[ai][bj][m][0]; *(f32x4*)(Z + row * 1024 + col + 4) = r1 * DN_ALPHA + acc[ai][bj][m][1]; } } }
};
struct EpiSwiGLU { static constexpr bool PERM = true, AFTER_DRAIN = false; bf16_t* H;
    __device__ __forceinline__ void operator()(const f32x4 (&acc)[2][2][4][2], const Unit& u, int wr, int wc, int fr, int fq) const {
        EPI_LOOP_AM { const size_t row = EPI_ROW; f32x4 v[2];
#pragma unroll
            for (int n = 0; n < 2; ++n) { const f32x4 g = acc[ai][0][m][n], up = acc[ai][1][m][n];
#pragma unroll
                for (int k = 0; k < 4; ++k) v[n][k] = g[k] * __builtin_amdgcn_rcpf(1.f + __expf(-g[k])) * up[k]; }
            *(u32x4*)(H + row * 2816 + u.pn * HALF + wc * 32 + 8 * fq) = pack8(v[0], v[1]); } }
};
template <class Epi, class Sched, bool ALIGN_EPI = false, bool SP2 = false>
__device__ __forceinline__ void gemm_phase(PG8_LAS unsigned char* lds, const Gemm g, const Sched& S, const Epi& E) {
    const int tid = threadIdx.x, wid = __builtin_amdgcn_readfirstlane(tid >> 6), lane = tid & 63, wr = wid >> 2, wc = wid & 3, fr = lane & 15, fq = lane >> 4;
    const int K = g.K, nt = K / BK;
    unsigned voffA[2], voffB[2];
#pragma unroll
    for (int i = 0; i < 2; ++i) { int R, C; stage_rc(tid * 16 + i * 8192, R, C); const int Rb = Epi::PERM ? ((R & ~31) + perm32(R & 31)) : R;
        voffA[i] = (unsigned)(R * K + C) * 2u; voffB[i] = (unsigned)(Rb * K + C) * 2u; }
    const size_t kstep = (size_t)(BK * 2);
    const size_t hstep = (size_t)HALF * K * 2;
    const size_t tstep = 2 * hstep;
    const unsigned ldsw = (unsigned)wid * 1024u;
    const int aoff = lds_byte(wr * 64 + fr, fq * 8), boff = lds_byte(wc * 32 + fr, fq * 8);
#define PG8_SA(b, h) (((b) * 2 + (h)) * HTB)
#define PG8_SB(b, h) ((4 + (b) * 2 + (h)) * HTB)
#define PG8_STAGE(bufoff, gbase, voff) do { _Pragma("unroll") for (int _i = 0; _i < 2; ++_i) \
        __builtin_amdgcn_global_load_lds((const unsigned*)((const char*)(gbase) + (voff)[_i]), (PG8_LAS unsigned*)(lds + (bufoff) + ldsw + _i * 8192), 16, 0, 0); } while (0)
#define PG8_LDA(dst, b, h) do { _Pragma("unroll") for (int m = 0; m < 4; ++m) _Pragma("unroll") for (int k = 0; k < 2; ++k) dst[m][k] = *(const PG8_LAS bf16x8*)(lds + PG8_SA(b, h) + aoff + m * 2048 + k * 1024); } while (0)
#define PG8_LDB(dst, b, h) do { _Pragma("unroll") for (int n = 0; n < 2; ++n) _Pragma("unroll") for (int k = 0; k < 2; ++k) dst[n][k] = *(const PG8_LAS bf16x8*)(lds + PG8_SB(b, h) + boff + n * 2048 + k * 1024); } while (0)
#define PG8_MMA(ai, bj, At, Bt) do { __builtin_amdgcn_s_setprio(1); _Pragma("unroll") for (int m = 0; m < 4; ++m) _Pragma("unroll") for (int n = 0; n < 2; ++n) _Pragma("unroll") for (int k = 0; k < 2; ++k) \
        acc[ai][bj][m][n] = __builtin_amdgcn_mfma_f32_16x16x32_bf16(Bt[n][k], At[m][k], acc[ai][bj][m][n], 0, 0, 0); __builtin_amdgcn_s_setprio(0); } while (0)
#define PG8_WAIT_V(n) asm volatile("s_waitcnt vmcnt(" #n ")" ::: "memory")
#define PG8_WAIT_L(n) asm volatile("s_waitcnt lgkmcnt(" #n ")" ::: "memory")
#define PG8_BAR __builtin_amdgcn_s_barrier()
#define PG8_SCHED __builtin_amdgcn_sched_barrier(0)
    Unit cur, nxt; int ui = 0;
    if (!S.next(0, cur)) return;
    f32x4 acc[2][2][4][2];
#pragma unroll
    for (int a = 0; a < 2; ++a)
#pragma unroll
        for (int b = 0; b < 2; ++b)
#pragma unroll
            for (int m = 0; m < 4; ++m)
#pragma unroll
                for (int n = 0; n < 2; ++n) acc[a][b][m][n] = (f32x4){0.f, 0.f, 0.f, 0.f};
    bf16x8 At[4][2], B0[2][2], B1[2][2];
    const char* cA = (const char*)g.A + (size_t)cur.pm * tstep; const char* cB = (const char*)g.Bt + (size_t)cur.pn * tstep;
    S.a_ready(cur);
    if constexpr (SP2) {
        PG8_STAGE(PG8_SB(0, 0), cB, voffB); PG8_STAGE(PG8_SB(0, 1), cB + hstep, voffB); PG8_STAGE(PG8_SA(0, 0), cA, voffA); PG8_STAGE(PG8_SA(0, 1), cA + hstep, voffA);
        if (wr == 1) PG8_BAR;
        PG8_WAIT_V(2); PG8_BAR;
        PG8_STAGE(PG8_SB(1, 0), cB + kstep, voffB); PG8_STAGE(PG8_SA(1, 0), cA + kstep, voffA); PG8_STAGE(PG8_SB(1, 1), cB + hstep + kstep, voffB);
        PG8_WAIT_V(6); PG8_BAR;
    } else {
        PG8_STAGE(PG8_SB(0, 0), cB, voffB); PG8_STAGE(PG8_SA(0, 0), cA, voffA); PG8_STAGE(PG8_SB(0, 1), cB + hstep, voffB); PG8_STAGE(PG8_SA(0, 1), cA + hstep, voffA);
        if (wr == 1) PG8_BAR;
        PG8_WAIT_V(4); PG8_BAR;
        PG8_STAGE(PG8_SB(1, 0), cB + kstep, voffB); PG8_STAGE(PG8_SA(1, 0), cA + kstep, voffA); PG8_STAGE(PG8_SB(1, 1), cB + hstep + kstep, voffB);
        PG8_WAIT_V(6); PG8_BAR;
    }
    for (;;) {
        const bool has_next = S.next(ui + 1, nxt);
        const char* nA = has_next ? (const char*)g.A + (size_t)nxt.pm * tstep : cA; const char* nB = has_next ? (const char*)g.Bt + (size_t)nxt.pn * tstep : cB;
        for (int t = 0; t < nt; t += 2) {
            const bool last = (t == nt - 2);
            const char* a1 = cA + (size_t)(t + 1) * kstep;
            const char* a2 = last ? nA : cA + (size_t)(t + 2) * kstep; const char* b2 = last ? nB : cB + (size_t)(t + 2) * kstep;
            const char* a3 = a2 + kstep; const char* b3 = b2 + kstep;
            if (last && has_next) S.a_ready(nxt);
            if constexpr (SP2) {
            PG8_LDB(B0, 0, 0); PG8_LDB(B1, 0, 1); PG8_SCHED; PG8_LDA(At, 0, 0); PG8_STAGE(PG8_SA(1, 1), a1 + hstep, voffA);
            PG8_WAIT_V(8); PG8_WAIT_L(0); PG8_BAR; PG8_MMA(0, 0, At, B0); PG8_MMA(0, 1, At, B1); PG8_BAR; PG8_SCHED;
            PG8_LDA(At, 0, 1); PG8_STAGE(PG8_SB(0, 0), b2, voffB); PG8_STAGE(PG8_SB(0, 1), b2 + hstep, voffB); PG8_STAGE(PG8_SA(0, 0), a2, voffA);
            PG8_WAIT_V(8); PG8_WAIT_L(0); PG8_BAR; PG8_MMA(1, 0, At, B0); PG8_MMA(1, 1, At, B1); PG8_BAR; PG8_SCHED;
            PG8_LDB(B0, 1, 0); PG8_LDB(B1, 1, 1); PG8_SCHED; PG8_LDA(At, 1, 0); PG8_STAGE(PG8_SA(0, 1), a2 + hstep, voffA);
            PG8_WAIT_V(8); PG8_WAIT_L(0); PG8_BAR; PG8_MMA(0, 0, At, B0); PG8_MMA(0, 1, At, B1); PG8_BAR; PG8_SCHED;
            PG8_LDA(At, 1, 1); PG8_STAGE(PG8_SB(1, 0), b3, voffB); PG8_STAGE(PG8_SB(1, 1), b3 + hstep, voffB); PG8_STAGE(PG8_SA(1, 0), a3, voffA);
            PG8_WAIT_V(8); PG8_WAIT_L(0); PG8_BAR; PG8_MMA(1, 0, At, B0); PG8_MMA(1, 1, At, B1); PG8_BAR; PG8_SCHED;
            } else {
            PG8_LDB(B0, 0, 0); PG8_SCHED; PG8_LDA(At, 0, 0); PG8_STAGE(PG8_SA(1, 1), a1 + hstep, voffA);
            PG8_WAIT_L(8); PG8_BAR; PG8_WAIT_L(0); PG8_MMA(0, 0, At, B0); PG8_BAR; PG8_SCHED;
            PG8_LDB(B1, 0, 1); PG8_STAGE(PG8_SB(0, 0), b2, voffB);
            PG8_BAR; PG8_WAIT_L(0); PG8_MMA(0, 1, At, B1); PG8_BAR;
            PG8_LDA(At, 0, 1); PG8_STAGE(PG8_SA(0, 0), a2, voffA);
            PG8_BAR; PG8_WAIT_L(0); PG8_MMA(1, 0, At, B0); PG8_BAR; PG8_SCHED;
            PG8_STAGE(PG8_SB(0, 1), b2 + hstep, voffB);
            PG8_WAIT_V(6); PG8_BAR; PG8_MMA(1, 1, At, B1); PG8_BAR;
            PG8_LDB(B0, 1, 0); PG8_SCHED; PG8_LDA(At, 1, 0); PG8_STAGE(PG8_SA(0, 1), a2 + hstep, voffA);
            PG8_WAIT_L(8); PG8_BAR; PG8_WAIT_L(0); PG8_MMA(0, 0, At, B0); PG8_BAR; PG8_SCHED;
            PG8_LDB(B1, 1, 1); PG8_STAGE(PG8_SB(1, 0), b3, voffB);
            PG8_BAR; PG8_WAIT_L(0); PG8_MMA(0, 1, At, B1); PG8_BAR;
            PG8_LDA(At, 1, 1); PG8_STAGE(PG8_SA(1, 0), a3, voffA);
            PG8_BAR; PG8_WAIT_L(0); PG8_MMA(1, 0, At, B0); PG8_BAR; PG8_SCHED;
            PG8_STAGE(PG8_SB(1, 1), b3 + hstep, voffB);
            PG8_WAIT_V(6); PG8_BAR; PG8_MMA(1, 1, At, B1); PG8_BAR;
            }
        }
        if constexpr (ALIGN_EPI) { if (wr == 0) PG8_BAR; }
        if constexpr (!Epi::AFTER_DRAIN) { E(acc, cur, wr, wc, fr, fq); S.done(cur); }
        if (!has_next) break;
#pragma unroll
        for (int a = 0; a < 2; ++a)
#pragma unroll
            for (int b = 0; b < 2; ++b)
#pragma unroll
                for (int m = 0; m < 4; ++m)
#pragma unroll
                    for (int n = 0; n < 2; ++n) acc[a][b][m][n] = (f32x4){0.f, 0.f, 0.f, 0.f};
        cur = nxt; cA = nA; cB = nB; ++ui;
        if constexpr (ALIGN_EPI) { if (wr == 1) PG8_BAR; }
    }
    PG8_WAIT_V(0);
    if constexpr (!ALIGN_EPI) { if (wr == 0) PG8_BAR; }
    PG8_BAR;
    if constexpr (Epi::AFTER_DRAIN) { E.fused(acc, cur, wr, wc, fr, fq, lds, wid, lane); S.done(cur); }
#undef PG8_SA
#undef PG8_SB
#undef PG8_STAGE
#undef PG8_LDA
#undef PG8_LDB
#undef PG8_MMA
#undef PG8_WAIT_V
#undef PG8_WAIT_L
#undef PG8_BAR
#undef PG8_SCHED
}
}
#define LAS __attribute__((address_space(3)))
typedef unsigned short bf16;
typedef short bf16x8 __attribute__((ext_vector_type(8)));
typedef float f32x4 __attribute__((ext_vector_type(4)));
typedef float f32x16 __attribute__((ext_vector_type(16)));
typedef unsigned u32x4 __attribute__((ext_vector_type(4)));
typedef unsigned u32x2 __attribute__((ext_vector_type(2)));
typedef unsigned long long u64;
constexpr int NWAVES = 8, NTHR = 512;
constexpr int BATCH = 8, SEQ = 4096, DM = 1024, M = BATCH * SEQ, FFN = 2816;
constexpr int NPROJ = 3840, NVT = 1536, NGATE = 2048, NGU = 5632;
constexpr size_t MiB = 1u << 20;
constexpr size_t WS_CTL = 0;
constexpr size_t WS_WIN = 1 * MiB, WS_WV = WS_WIN + (size_t)NPROJ * DM * 2, WS_WGATE = WS_WV + (size_t)NVT * DM * 2, WS_WA = WS_WGATE + (size_t)NGATE * DM * 2,
                 WS_WB = WS_WA + (size_t)DM * 768 * 2, WS_WO = WS_WB + (size_t)DM * 256 * 2, WS_WGU = WS_WO + (size_t)DM * DM * 2, WS_WD = WS_WGU + (size_t)NGU * DM * 2,
                 WS_WEND = WS_WD + (size_t)DM * FFN * 2;
static_assert(WS_WEND <= 36 * MiB, "weights");
constexpr size_t WS_CS = 36 * MiB, WS_MASK = 38 * MiB, WS_XB = 54 * MiB, WS_QA = 118 * MiB, WS_KA = 166 * MiB, WS_VAT = 214 * MiB, WS_QB = 262 * MiB, WS_KB = 310 * MiB,
                 WS_VBT = 358 * MiB, WS_QI = 406 * MiB, WS_KIWI = 438 * MiB, WS_LSE = 446 * MiB, WS_OBC = 448 * MiB, WS_END = 464 * MiB;
constexpr size_t WS_GATE = 310 * MiB  , WS_MIXED = 166 * MiB  , WS_X1B = 54 * MiB  , WS_H = 118 * MiB  ;
static_assert(WS_H + (size_t)M * FFN * 2 <= WS_GATE + 128 * MiB, "map");
constexpr int LDS_BYTES = 147456;
constexpr int SCP = 4128;

__device__ __forceinline__ unsigned f2bf(float f) { unsigned u = __builtin_bit_cast(unsigned, f); return (u + 0x7fffu + ((u >> 16) & 1u)) >> 16; }
__device__ __forceinline__ unsigned pk2(float lo, float hi) { return f2bf(lo) | (f2bf(hi) << 16); }
__device__ __forceinline__ float bf_lo(unsigned w) { return __uint_as_float(w << 16); }
__device__ __forceinline__ float bf_hi(unsigned w) { return __uint_as_float(w & 0xffff0000u); }
__device__ __forceinline__ float wave_sum(float v) {
#pragma unroll
    for (int o = 1; o < 64; o <<= 1) v += __shfl_xor(v, o);
    return v; }

struct Args { const float* in[14]; float* out; unsigned char* ws; int ph_lo, ph_hi; };

__device__ __forceinline__ void tr_item(const float* W, int ld, int K, int c0, int nvalid, bf16* WT, int r0, int k0, LAS float* scr, int lane) {
#pragma unroll 8
    for (int i = 0; i < 32; ++i) { const int kk = 2 * i + (lane >> 5), n = lane & 31; scr[kk * 33 + n] = (n < nvalid) ? W[(size_t)(k0 + kk) * ld + c0 + n] : 0.f; }
    asm volatile("s_waitcnt lgkmcnt(0)" ::: "memory");
    const int c = lane & 7;
#pragma unroll
    for (int j = 0; j < 4; ++j) { const int n = (lane >> 3) + 8 * j; const LAS float* s = scr + (8 * c) * 33 + n;
        u32x4 o; o.x = pk2(s[0 * 33], s[1 * 33]); o.y = pk2(s[2 * 33], s[3 * 33]); o.z = pk2(s[4 * 33], s[5 * 33]); o.w = pk2(s[6 * 33], s[7 * 33]);
        *(u32x4*)(WT + (size_t)(r0 + n) * K + k0 + 8 * c) = o; }
    asm volatile("s_waitcnt lgkmcnt(0)" ::: "memory");
}
__device__ __forceinline__ void p0_prologue(const Args& a, LAS unsigned char* lds, int gw, int NGW, int wave, int lane) {
    unsigned char* ws = a.ws;
    LAS float* scr = (LAS float*)(lds + wave * 16384);
    const float* w_in = a.in[2];
    int it = gw;
    for (;; it += NGW) {
        int r = it; const float* src; int ld, K, col0, ncols, row0, mode = 0; bf16* dst;
#define SEC(S, LD, KK, C0, NC, DST, R0, MODE) { const int n_ = ((KK) / 64) * (((NC) + 31) / 32); if (r < n_) { src = (S); ld = (LD); K = (KK); col0 = (C0); ncols = (NC); dst = (bf16*)(ws + (DST)); row0 = (R0); mode = (MODE); goto found; } r -= n_; }
        SEC(w_in, 7240, 1024, 0, 768, WS_WIN, 0, 0)
        SEC(w_in, 7240, 1024, 768, 768, WS_WIN, 768, 0)
        SEC(w_in, 7240, 1024, 1536, 768, WS_WV, 0, 0)
        SEC(w_in, 7240, 1024, 2304, 768, WS_WIN, 1536, 0)
        SEC(w_in, 7240, 1024, 3072, 768, WS_WIN, 2304, 0)
        SEC(w_in, 7240, 1024, 3840, 768, WS_WV, 768, 0)
        SEC(w_in, 7240, 1024, 4608, 512, WS_WIN, 3072, 0)
        SEC(w_in, 7240, 1024, 5120, 64, WS_WIN, 3584, 0)
        SEC(w_in, 7240, 1024, 5184, 8, WS_WIN, 3648, 0)
        SEC(w_in, 7240, 1024, 5192, 2048, WS_WGATE, 0, 0)
        SEC(a.in[4], 1024, 768, 0, 1024, WS_WA, 0, 0)
        SEC(a.in[5], 1024, 256, 0, 1024, WS_WB, 0, 0)
        SEC(a.in[6], 1024, 1024, 0, 1024, WS_WO, 0, 0)
        SEC(a.in[9], 2816, 1024, 0, 2816, WS_WGU, 0, 1)
        SEC(a.in[10], 2816, 1024, 0, 2816, WS_WGU, 128, 1)
        SEC(a.in[11], 1024, 2816, 0, 1024, WS_WD, 0, 0)
#undef SEC
        break;
    found:;
        const int nblk = (ncols + 31) / 32, kb = r / nblk, nb = r % nblk, n0 = 32 * nb;
        const int nvalid = (ncols - n0) < 32 ? (ncols - n0) : 32;
        const int r0 = row0 + (mode ? 256 * (n0 / 128) + (n0 % 128) : n0);
        tr_item(src, ld, K, col0 + n0, nvalid, dst, r0, 64 * kb, scr, lane);
    }
    { u32x4* p = (u32x4*)(ws + WS_WIN + (size_t)3680 * DM * 2); const int n16 = 160 * DM * 2 / 16;
      for (int i = gw * 64 + lane; i < n16; i += NGW * 64) p[i] = (u32x4){0u, 0u, 0u, 0u}; }
    { const f32x4* x4 = (const f32x4*)a.in[0]; u32x4* xb = (u32x4*)(ws + WS_XB); const int n8 = M * DM / 8;
      for (int i = gw * 64 + lane; i < n8; i += NGW * 64) { const f32x4 p = x4[2 * i], q = x4[2 * i + 1]; u32x4 o; o.x = pk2(p[0], p[1]); o.y = pk2(p[2], p[3]); o.z = pk2(q[0], q[1]); o.w = pk2(q[2], q[3]); xb[i] = o; } }
    { const int* pos = (const int*)a.in[1]; float* cs = (float*)(ws + WS_CS);
      for (int i = gw * 64 + lane; i < M * 8; i += NGW * 64) { const int row = i >> 3, f = i & 7;
          const float inv = powf(500000.0f, -(float)(2 * f) / 16.0f); const float ang = (float)pos[row] * inv;
          cs[row * 16 + f] = cosf(ang); cs[row * 16 + 8 + f] = sinf(ang); } }
}

#define WRL(dst, sval, ln) asm volatile("s_nop 4\n\tv_writelane_b32 %0, %1, %2\n\ts_nop 1" : "+v"(dst) : "s"(sval), "i"(ln))
__device__ __forceinline__ void indexer_phase(LAS unsigned char* lds, const bf16* QI, const bf16* KIWI, u64* MASK, int blk, int nblk, int wid, int lane) {
    LAS float* sc = (LAS float*)lds;
    const int rt = wid & 1, kg = wid >> 1, m = lane & 31, kh = lane >> 5;
    for (int u = blk; u < BATCH * (SEQ / 8); u += nblk) {
        const int b = u & 7, t0 = (u >> 3) * 8;
        const size_t rb = (size_t)b * SEQ;
        {
            const int qloc = 2 * ((m >> 2) & 1) + ((m >> 4) & 1), head = 4 * ((m >> 3) & 1) + (m & 3);
            const bf16* qp = QI + (rb + t0 + 4 * rt + qloc) * 512 + head * 64 + 8 * kh;
            bf16x8 qf[4];
#pragma unroll
            for (int kk = 0; kk < 4; ++kk) qf[kk] = *(const bf16x8*)(qp + 16 * kk);
            float wv[2][8];
#pragma unroll
            for (int i = 0; i < 2; ++i) { const u32x4 w = *(const u32x4*)(KIWI + (rb + t0 + 4 * rt + 2 * kh + i) * 128 + 64);
                wv[i][0] = bf_lo(w.x); wv[i][1] = bf_hi(w.x); wv[i][2] = bf_lo(w.y); wv[i][3] = bf_hi(w.y); wv[i][4] = bf_lo(w.z); wv[i][5] = bf_hi(w.z); wv[i][6] = bf_lo(w.w); wv[i][7] = bf_hi(w.w); }
            const int nkt = (t0 + 7) / 32 + 1;
            for (int kt = kg; kt < nkt; kt += 4) {
                const int key = 32 * kt + m; const bf16* kp = KIWI + (rb + key) * 128 + 8 * kh;
                bf16x8 kf[4];
#pragma unroll
                for (int kk = 0; kk < 4; ++kk) kf[kk] = *(const bf16x8*)(kp + 16 * kk);
                f32x16 acc = {0, 0, 0, 0, 0, 0, 0, 0, 0, 0, 0, 0, 0, 0, 0, 0};
#pragma unroll
                for (int kk = 0; kk < 4; ++kk) acc = __builtin_amdgcn_mfma_f32_32x32x16_bf16(qf[kk], kf[kk], acc, 0, 0, 0);
#pragma unroll
                for (int i = 0; i < 2; ++i) { float s = 0.f;
#pragma unroll
                    for (int h = 0; h < 8; ++h) s += wv[i][h] * fmaxf(acc[8 * i + h], 0.f);
                    sc[(4 * rt + 2 * kh + i) * SCP + key] = s + 0.0f; }
            }
        }
        __syncthreads();
        {
            const int t = t0 + wid, jmax = t >> 6;
            unsigned uv[64]; const int lim = t - lane;
#pragma unroll
            for (int j = 0; j < 64; ++j) { const unsigned bts = __float_as_uint(sc[wid * SCP + 64 * j + lane]);
                const unsigned s = bts ^ ((unsigned)((int)bts >> 31) | 0x80000000u); uv[j] = (64 * j <= lim) ? s : 0u; }
            unsigned mw_lo = 0u, mw_hi = 0u;
            if (t < 256) {
#pragma unroll
                for (int j = 0; j < 4; ++j) { const u64 wd = __ballot(64 * j + lane <= t); WRL(mw_lo, (unsigned)wd, j); WRL(mw_hi, (unsigned)(wd >> 32), j); }
            } else {
                unsigned ustar = 0u;
                for (int bit = 31; bit >= 0; --bit) { const unsigned cand = ustar | (1u << bit); int cnt = 0;
#pragma unroll
                    for (int g = 0; g < 16; ++g) if (4 * g <= jmax) {
                        cnt += __popcll(__ballot(uv[4 * g] >= cand)) + __popcll(__ballot(uv[4 * g + 1] >= cand)) + __popcll(__ballot(uv[4 * g + 2] >= cand)) + __popcll(__ballot(uv[4 * g + 3] >= cand)); __builtin_amdgcn_sched_barrier(0); }
                    if (cnt >= 256) ustar = cand; }
                int cgt = 0;
#pragma unroll
                for (int j = 0; j < 64; ++j) { cgt += __popcll(__ballot(uv[j] > ustar)); __builtin_amdgcn_sched_barrier(0); }
                int remaining = 256 - cgt; asm volatile("" : "+s"(ustar));
#pragma unroll
                for (int j = 0; j < 64; ++j) { const bool eq = uv[j] == ustar; const u64 em = __ballot(eq);
                    const int rank = __builtin_amdgcn_mbcnt_hi((unsigned)(em >> 32), __builtin_amdgcn_mbcnt_lo((unsigned)em, 0u));
                    const bool sel = (uv[j] > ustar) || (eq && rank < remaining); const int c = __popcll(em); remaining -= (c < remaining ? c : remaining);
                    const u64 wd = __ballot(sel); WRL(mw_lo, (unsigned)wd, j); WRL(mw_hi, (unsigned)(wd >> 32), j); __builtin_amdgcn_sched_barrier(0); }
            }
            MASK[(rb + t) * 64 + lane] = ((u64)mw_hi << 32) | (u64)mw_lo;
        }
        __syncthreads();
    }
}

__device__ __forceinline__ int pi32(int r) { return (r & 0x13) | ((r & 4) << 1) | ((r & 8) >> 1); }
__device__ __forceinline__ void attn_unit(LAS unsigned char* lds, const bf16* Q, const bf16* K, const bf16* VT, bf16* O, float* LSE, const u64* MASK,
                                          bool isB, int b, int h, int q0, int t_lo, int t_hi, int win, int dsh, int tid, int wid, int lane) {
    const int ql = lane & 31, hi = lane >> 5;
    const size_t rb = (size_t)b * SEQ; const int tq = q0 + 32 * wid + ql; const size_t rowq = rb + tq;
    bf16x8 qf[4];
#pragma unroll
    for (int kk = 0; kk < 4; ++kk) qf[kk] = *(const bf16x8*)(Q + rowq * 768 + h * 64 + 16 * kk + 8 * hi);
    f32x16 o0 = {0, 0, 0, 0, 0, 0, 0, 0, 0, 0, 0, 0, 0, 0, 0, 0}, o1 = o0;
    float m_run = -1e30f, l_run = 0.f;
    const int sr = tid >> 3, scc = tid & 7;
    const bf16* ksrc = K + (rb + sr) * 768 + h * 64 + 8 * scc;
    const bf16* vsrc = VT + (size_t)(h * 64 + sr) * M + rb + 8 * scc;
    const int swoff = (sr * 72 + 8 * scc) * 2;
    const int kroff = (pi32(ql) * 72 + 8 * hi) * 2, vroff = 9216 + (ql * 72 + 8 * hi) * 2;
    const u64* mrow = MASK + rowq * 64;
    u32x4 kreg = *(const u32x4*)(ksrc + (size_t)64 * t_lo * 768), vreg = *(const u32x4*)(vsrc + 64 * t_lo);
    u64 mw_next = isB ? 0ull : mrow[t_lo];
    __syncthreads();
    *(LAS u32x4*)(lds + swoff) = kreg; *(LAS u32x4*)(lds + 9216 + swoff) = vreg;
    __syncthreads();
    const u64 pat = (dsh == 0 ? ~0ull : (dsh == 2 ? 0x1111111111111111ull : 0x0001000100010001ull)) << (tq & ((1 << dsh) - 1));
    for (int t = t_lo; t < t_hi; ++t) {
        const int cur = (t - t_lo) & 1; LAS unsigned char* buf = lds + cur * 18432;
        const bool more = (t + 1 < t_hi);
        if (more) { kreg = *(const u32x4*)(ksrc + (size_t)64 * (t + 1) * 768); vreg = *(const u32x4*)(vsrc + 64 * (t + 1)); }
        u64 mw;
        if (isB) { const int hi_i = tq - 64 * t, lo_i = hi_i - win;
            const u64 up = hi_i >= 63 ? ~0ull : (hi_i < 0 ? 0ull : ((2ull << hi_i) - 1ull)); const u64 lw = lo_i <= 0 ? ~0ull : (lo_i > 63 ? 0ull : (~0ull << lo_i));
            mw = pat & up & lw;
        } else { mw = mw_next; if (more) mw_next = mrow[t + 1]; }
        f32x16 s0 = {0, 0, 0, 0, 0, 0, 0, 0, 0, 0, 0, 0, 0, 0, 0, 0}, s1 = s0;
#pragma unroll
        for (int kk = 0; kk < 4; ++kk) { const bf16x8 a0 = *(const LAS bf16x8*)(buf + kroff + 32 * kk), a1 = *(const LAS bf16x8*)(buf + kroff + 32 * 144 + 32 * kk);
            s0 = __builtin_amdgcn_mfma_f32_32x32x16_bf16(a0, qf[kk], s0, 0, 0, 0); s1 = __builtin_amdgcn_mfma_f32_32x32x16_bf16(a1, qf[kk], s1, 0, 0, 0); }
        const unsigned m0 = (unsigned)(mw >> (8 * hi)), m1 = (unsigned)(mw >> (32 + 8 * hi));
        const unsigned NEGB = 0xF149F2CAu;
        float mx = -1e30f;
#pragma unroll
        for (int j = 0; j < 16; ++j) { const int bp = (j & 7) + 16 * (j >> 3);
            const unsigned k0 = (unsigned)__builtin_amdgcn_sbfe((int)m0, bp, 1), k1 = (unsigned)__builtin_amdgcn_sbfe((int)m1, bp, 1);
            s0[j] = __uint_as_float((__float_as_uint(s0[j]) & k0) | (NEGB & ~k0)); s1[j] = __uint_as_float((__float_as_uint(s1[j]) & k1) | (NEGB & ~k1));
            mx = fmaxf(mx, fmaxf(s0[j], s1[j])); }
        mx = fmaxf(mx, __shfl_xor(mx, 32));
        if (__any(mx > m_run)) { const float mn = fmaxf(m_run, mx); const float f = __builtin_amdgcn_exp2f(m_run - mn); m_run = mn; l_run *= f;
#pragma unroll
            for (int j = 0; j < 16; ++j) { o0[j] *= f; o1[j] *= f; } }
        float ps = 0.f;
#pragma unroll
        for (int j = 0; j < 16; ++j) { s0[j] = __builtin_amdgcn_exp2f(s0[j] - m_run); s1[j] = __builtin_amdgcn_exp2f(s1[j] - m_run); ps += s0[j] + s1[j]; }
        l_run += ps;
        bf16x8 pf[2][2];
#pragma unroll
        for (int k2 = 0; k2 < 2; ++k2) { u32x4 w0, w1;
            w0.x = pg8::cvt_pk_bf16(s0[8 * k2 + 0], s0[8 * k2 + 1]); w0.y = pg8::cvt_pk_bf16(s0[8 * k2 + 2], s0[8 * k2 + 3]); w0.z = pg8::cvt_pk_bf16(s0[8 * k2 + 4], s0[8 * k2 + 5]); w0.w = pg8::cvt_pk_bf16(s0[8 * k2 + 6], s0[8 * k2 + 7]);
            w1.x = pg8::cvt_pk_bf16(s1[8 * k2 + 0], s1[8 * k2 + 1]); w1.y = pg8::cvt_pk_bf16(s1[8 * k2 + 2], s1[8 * k2 + 3]); w1.z = pg8::cvt_pk_bf16(s1[8 * k2 + 4], s1[8 * k2 + 5]); w1.w = pg8::cvt_pk_bf16(s1[8 * k2 + 6], s1[8 * k2 + 7]);
            pf[0][k2] = __builtin_bit_cast(bf16x8, w0); pf[1][k2] = __builtin_bit_cast(bf16x8, w1); }
#pragma unroll
        for (int s = 0; s < 2; ++s)
#pragma unroll
            for (int k2 = 0; k2 < 2; ++k2) { const int co = (32 * s + 16 * k2) * 2;
                const bf16x8 v0 = *(const LAS bf16x8*)(buf + vroff + co), v1 = *(const LAS bf16x8*)(buf + vroff + 32 * 144 + co);
                o0 = __builtin_amdgcn_mfma_f32_32x32x16_bf16(v0, pf[s][k2], o0, 0, 0, 0); o1 = __builtin_amdgcn_mfma_f32_32x32x16_bf16(v1, pf[s][k2], o1, 0, 0, 0); }
        if (more) { LAS unsigned char* nb = lds + (cur ^ 1) * 18432; *(LAS u32x4*)(nb + swoff) = kreg; *(LAS u32x4*)(nb + 9216 + swoff) = vreg; }
        __syncthreads();
    }
    const float lt = l_run + __shfl_xor(l_run, 32); const float inv = 1.0f / lt;
    bf16* op = O + rowq * 768 + h * 64 + 4 * hi;
#pragma unroll
    for (int jg = 0; jg < 4; ++jg) { u32x2 w;
        w.x = pk2(o0[4 * jg] * inv, o0[4 * jg + 1] * inv); w.y = pk2(o0[4 * jg + 2] * inv, o0[4 * jg + 3] * inv); *(u32x2*)(op + 8 * jg) = w;
        w.x = pk2(o1[4 * jg] * inv, o1[4 * jg + 1] * inv); w.y = pk2(o1[4 * jg + 2] * inv, o1[4 * jg + 3] * inv); *(u32x2*)(op + 32 + 8 * jg) = w; }
    if (isB && hi == 0) LSE[rowq * 12 + h] = 0.6931471805599453f * (m_run + log2f(lt));
}
__device__ __forceinline__ void attn_phase(LAS unsigned char* lds, unsigned char* ws, unsigned* ctr, int tid, int wid, int lane) {
    LAS int* slot = (LAS int*)(lds + 40960);
    for (;;) {
        __syncthreads();
        if (tid == 0) *slot = (int)atomicAdd(ctr, 1u);
        __syncthreads();
        const int k = *slot;
        if (k >= 3072) break;
        if (k < 1536) { const int qb = 15 - k / 96, rem = k % 96, b = rem / 12, h = rem % 12;
            attn_unit(lds, (const bf16*)(ws + WS_QA), (const bf16*)(ws + WS_KA), (const bf16*)(ws + WS_VAT), (bf16*)(ws + WS_QA), nullptr, (const u64*)(ws + WS_MASK),
                      false, b, h, 256 * qb, 0, 4 * qb + 4, 0, 0, tid, wid, lane);
        } else { const int k2 = k - 1536, gs = 2 - k2 / 512, r = k2 % 512, qb = 15 - r / 32, rem = r % 32, b = rem / 4, hg = rem % 4;
            const int win = gs == 0 ? 128 : (gs == 1 ? 512 : 2048), dsh = gs == 0 ? 0 : (gs == 1 ? 2 : 4);
            const int q0 = 256 * qb; const int lo = q0 - win; const int t_lo = lo > 0 ? lo / 64 : 0;
            attn_unit(lds, (const bf16*)(ws + WS_QB), (const bf16*)(ws + WS_KB), (const bf16*)(ws + WS_VBT), (bf16*)(ws + WS_QB), (float*)(ws + WS_LSE), nullptr,
                      true, b, gs * 4 + hg, q0, t_lo, 4 * qb + 4, win, dsh, tid, wid, lane);
        }
    }
}

__device__ __forceinline__ void combine_b(unsigned char* ws, int gw, int NGW, int lane) {
    const bf16* OB = (const bf16*)(ws + WS_QB); const float* LSE = (const float*)(ws + WS_LSE); bf16* OBC = (bf16*)(ws + WS_OBC);
    for (int row = gw; row < M; row += NGW) { const int hg = lane >> 4, c = (lane & 15) * 4;
        const float l0 = LSE[(size_t)row * 12 + hg], l1 = LSE[(size_t)row * 12 + 4 + hg], l2 = LSE[(size_t)row * 12 + 8 + hg];
        const float mx = fmaxf(l0, fmaxf(l1, l2)); const float e0 = __expf(l0 - mx), e1 = __expf(l1 - mx), e2 = __expf(l2 - mx); const float inv = 1.f / (e0 + e1 + e2);
        const u32x2 a = *(const u32x2*)(OB + (size_t)row * 768 + hg * 64 + c), bb = *(const u32x2*)(OB + (size_t)row * 768 + 256 + hg * 64 + c), cc = *(const u32x2*)(OB + (size_t)row * 768 + 512 + hg * 64 + c);
        const float a0 = e0 * inv, a1 = e1 * inv, a2 = e2 * inv; u32x2 o;
        o.x = pk2(a0 * bf_lo(a.x) + a1 * bf_lo(bb.x) + a2 * bf_lo(cc.x), a0 * bf_hi(a.x) + a1 * bf_hi(bb.x) + a2 * bf_hi(cc.x));
        o.y = pk2(a0 * bf_lo(a.y) + a1 * bf_lo(bb.y) + a2 * bf_lo(cc.y), a0 * bf_hi(a.y) + a1 * bf_hi(bb.y) + a2 * bf_hi(cc.y));
        *(u32x2*)(OBC + (size_t)row * 256 + hg * 64 + c) = o; }
}
__device__ __forceinline__ void ln_rows(float* Z, const float* g, const float* bta, bf16* OB16, int gw, int NGW, int lane) {
    f32x4 gv[4], bv[4];
#pragma unroll
    for (int j = 0; j < 4; ++j) { gv[j] = ((const f32x4*)g)[lane + 64 * j]; bv[j] = ((const f32x4*)bta)[lane + 64 * j]; }
    for (int row = gw; row < M; row += NGW) { f32x4* zr = (f32x4*)(Z + (size_t)row * DM) + lane; f32x4 v[4]; float s = 0.f;
#pragma unroll
        for (int j = 0; j < 4; ++j) { v[j] = zr[64 * j]; s += (v[j][0] + v[j][1]) + (v[j][2] + v[j][3]); }
        const float mean = wave_sum(s) * (1.f / DM); float s2 = 0.f;
#pragma unroll
        for (int j = 0; j < 4; ++j) { v[j] = v[j] - mean; s2 += (v[j][0] * v[j][0] + v[j][1] * v[j][1]) + (v[j][2] * v[j][2] + v[j][3] * v[j][3]); }
        const float rstd = 1.f / sqrtf(wave_sum(s2) * (1.f / DM) + 1e-5f);
#pragma unroll
        for (int j = 0; j < 4; ++j) { const f32x4 y = v[j] * rstd * gv[j] + bv[j]; zr[64 * j] = y;
            if (OB16) { u32x2 w; w.x = pk2(y[0], y[1]); w.y = pk2(y[2], y[3]); *((u32x2*)(OB16 + (size_t)row * DM) + lane + 64 * j) = w; } } }
}

__global__ void __launch_bounds__(NTHR, 2) fwd_megakernel(Args args) {
    extern __shared__ __attribute__((aligned(16))) unsigned char lds_raw[];
    LAS unsigned char* lds = (LAS unsigned char*)lds_raw;
    const int tid = threadIdx.x, lane = tid & 63, wid = __builtin_amdgcn_readfirstlane(tid >> 6);
    const int G = gridDim.x, blk = blockIdx.x, gw = blk * NWAVES + wid, NGW = G * NWAVES;
    unsigned char* ws = args.ws;
    const int lo = args.ph_lo, hi = args.ph_hi;
#ifndef PH_MASK
#define PH_MASK 0xFFFF
#endif
#define IN(k) (((PH_MASK >> (k)) & 1) && lo <= (k) && (k) < hi)
#define SEAM(k) do { if (IN(k) && IN((k) + 1)) { __threadfence(); cg::this_grid().sync(); __threadfence(); } } while (0)
    using namespace pg8;
    if (IN(0)) { p0_prologue(args, lds, gw, NGW, wid, lane); }
    SEAM(0);
    if (IN(1)) {
        { Gemm g{(const bf16_t*)(ws + WS_XB), (const bf16_t*)(ws + WS_WIN), M, NPROJ, DM}; StaticOrder S; S.init(M, NPROJ, G, blk);
          EpiProj E{(bf16_t*)(ws + WS_QA), (bf16_t*)(ws + WS_KA), (bf16_t*)(ws + WS_QB), (bf16_t*)(ws + WS_KB), (bf16_t*)(ws + WS_QI), (bf16_t*)(ws + WS_KIWI), (const float*)(ws + WS_CS)};
          gemm_phase<EpiProj, StaticOrder, true, true>(lds, g, S, E); }
        { Gemm g{(const bf16_t*)(ws + WS_WV), (const bf16_t*)(ws + WS_XB), NVT, M, DM}; StaticOrder S; S.init(NVT, M, G, blk);
          EpiBf16 E{(bf16_t*)(ws + WS_VAT), (bf16_t*)(ws + WS_VBT), M};
          gemm_phase<EpiBf16, StaticOrder, true, true>(lds, g, S, E); }
    }
    SEAM(1);
    if (IN(2)) indexer_phase(lds, (const bf16*)(ws + WS_QI), (const bf16*)(ws + WS_KIWI), (u64*)(ws + WS_MASK), blk, G, wid, lane);
    SEAM(2);
    if (IN(3)) attn_phase(lds, ws, (unsigned*)(ws + WS_CTL) + 64, tid, wid, lane);
    SEAM(3);
    if (IN(4)) {
        combine_b(ws, gw, NGW, lane);
        Gemm g{(const bf16_t*)(ws + WS_XB), (const bf16_t*)(ws + WS_WGATE), M, NGATE, DM}; StaticOrder S; S.init(M, NGATE, G, blk);
        EpiGate E{(bf16_t*)(ws + WS_GATE), NGATE, args.in[3]};
        gemm_phase<EpiGate, StaticOrder, true, true>(lds, g, S, E);
    }
    SEAM(4);
    if (IN(5)) {
        { Gemm g{(const bf16_t*)(ws + WS_QA), (const bf16_t*)(ws + WS_WA), M, DM, 768}; StaticOrder S; S.init(M, DM, G, blk);
          EpiBrA E{args.out, (const bf16_t*)(ws + WS_GATE)};
          gemm_phase<EpiBrA, StaticOrder, true, true>(lds, g, S, E); }
        { Gemm g{(const bf16_t*)(ws + WS_OBC), (const bf16_t*)(ws + WS_WB), M, DM, 256}; StaticOrder S; S.init(M, DM, G, blk);
          EpiBrB E{args.out, (const bf16_t*)(ws + WS_GATE), (bf16_t*)(ws + WS_MIXED)};
          gemm_phase<EpiBrB, StaticOrder, true, true>(lds, g, S, E); }
    }
    SEAM(5);
    if (IN(6)) {
        Gemm g{(const bf16_t*)(ws + WS_MIXED), (const bf16_t*)(ws + WS_WO), M, DM, DM}; StaticOrder S; S.init(M, DM, G, blk);
        EpiRes E{args.in[0], args.out};
        gemm_phase<EpiRes, StaticOrder, true, true>(lds, g, S, E);
    }
    SEAM(6);
    if (IN(7)) ln_rows(args.out, args.in[7], args.in[8], (bf16*)(ws + WS_X1B), gw, NGW, lane);
    SEAM(7);
    if (IN(8)) {
        Gemm g{(const bf16_t*)(ws + WS_X1B), (const bf16_t*)(ws + WS_WGU), M, NGU, DM}; StaticOrder S; S.init(M, NGU, G, blk);
        EpiSwiGLU E{(bf16_t*)(ws + WS_H)};
        gemm_phase<EpiSwiGLU, StaticOrder, true, true>(lds, g, S, E);
    }
    SEAM(8);
    if (IN(9)) {
        Gemm g{(const bf16_t*)(ws + WS_H), (const bf16_t*)(ws + WS_WD), M, DM, FFN}; StaticOrder S; S.init(M, DM, G, blk);
        EpiRes E{args.out, args.out};
        gemm_phase<EpiRes, StaticOrder, true, true>(lds, g, S, E);
    }
    SEAM(9);
    if (IN(10)) ln_rows(args.out, args.in[12], args.in[13], nullptr, gw, NGW, lane);
#undef IN
#undef SEAM
}

constexpr int NPHASE = 11;
extern "C" void kernel_launch(void* const* d_in, const int* in_sizes, int n_in, void* d_out, int out_size, void* d_ws, size_t ws_size, hipStream_t stream) {
    static int grid = 0;
    if (grid == 0) {
        if (n_in != 14 || in_sizes[0] != M * DM || out_size != M * DM || ws_size < WS_END) { fprintf(stderr, "kernel_launch: unexpected shapes / workspace (n_in %d, ws %zu); nothing launched\n", n_in, ws_size); grid = -1; return; }
        int dev = 0, cus = 0, per_cu = 0;
        if (hipGetDevice(&dev) != hipSuccess || hipDeviceGetAttribute(&cus, hipDeviceAttributeMultiprocessorCount, dev) != hipSuccess) { grid = -1; return; }
        if (hipFuncSetAttribute((const void*)fwd_megakernel, hipFuncAttributeMaxDynamicSharedMemorySize, LDS_BYTES) != hipSuccess) { fprintf(stderr, "kernel_launch: hipFuncSetAttribute failed\n"); grid = -1; return; }
        if (hipOccupancyMaxActiveBlocksPerMultiprocessor(&per_cu, (const void*)fwd_megakernel, NTHR, LDS_BYTES) != hipSuccess || per_cu < 1) { fprintf(stderr, "kernel_launch: occupancy query says %d\n", per_cu); per_cu = 1; }
        (void)hipGetLastError();
        grid = cus * per_cu;
    }
    if (grid < 0) return;
    (void)hipMemsetAsync((char*)d_ws + WS_CTL, 0, 4096, stream);
    Args a{};
    for (int i = 0; i < 14; ++i) a.in[i] = (const float*)d_in[i];
    a.out = (float*)d_out; a.ws = (unsigned char*)d_ws;
#if MK_N_LAUNCHES == 1
    a.ph_lo = 0; a.ph_hi = NPHASE;
    void* kargs[] = {&a};
    hipError_t e = hipLaunchCooperativeKernel((const void*)fwd_megakernel, dim3(grid), dim3(NTHR), kargs, LDS_BYTES, stream);
    if (e != hipSuccess) fprintf(stderr, "cooperative launch failed: %s (grid %d)\n", hipGetErrorString(e), grid);
#else
    for (int p = 0; p < NPHASE; ++p) { a.ph_lo = p; a.ph_hi = p + 1; hipLaunchKernelGGL(fwd_megakernel, dim3(grid), dim3(NTHR), LDS_BYTES, stream, a); }
#endif
}
```

```cpp
#include <hip/hip_runtime.h>
#include <hip/hip_cooperative_groups.h>
#include <cstdio>
#include <cstdint>
namespace cg = cooperative_groups;
#ifndef MK_N_LAUNCHES
#define MK_N_LAUNCHES 1
#endif
constexpr float C2 = 0.125f * 1.4426950408889634f;
constexpr float DN_ALPHA = 1.1892071150027210f;
namespace pg8 {
#define PG8_LAS __attribute__((address_space(3)))
typedef unsigned short bf16_t;
typedef short bf16x8 __attribute__((ext_vector_type(8)));
typedef float f32x4 __attribute__((ext_vector_type(4)));
typedef unsigned u32x4 __attribute__((ext_vector_type(4)));
constexpr int BM = 256, BK = 64, HALF = 128, HTB = HALF * BK * 2  , STAGE_BYTES = 8 * HTB, NXCD = 8, WGM = 8;

__host__ __device__ __forceinline__ int lds_byte(int r, int c) { const int st = (r >> 4) * 2 + (c >> 5), rr = r & 15, cc = c & 31, ob = rr * 64 + cc * 2; return st * 1024 + (ob ^ (((ob >> 9) & 1) << 5)); }
__host__ __device__ __forceinline__ void stage_rc(int b, int& R, int& C) { const int st = b / 1024, sb = b % 1024, swz = sb ^ (((sb >> 9) & 1) << 5); R = (st >> 1) * 16 + swz / 64; C = (st & 1) * 32 + (swz % 64) / 2; }
__host__ __device__ __forceinline__ int perm32(int rho) { const int n = rho >> 4, i = rho & 15; return 8 * (i >> 2) + 4 * n + (i & 3); }

struct Unit { int pm, pn; };
struct Gemm { const bf16_t* A; const bf16_t* Bt; int M, N, K; };

struct StaticOrder {
    int nM, nN, nwg, G, c;
    __host__ __device__ void init(int M, int N, int G_, int c_) { nM = M / BM; nN = N / BM; nwg = nM * nN; G = G_; c = c_; }
    __host__ __device__ bool next(int i, Unit& u) const {
        const long L = (long)i * G + c; if (L >= nwg) return false;
        int wgid = (int)L; { const int q = nwg / NXCD, r = nwg % NXCD, xcd = wgid % NXCD, off = wgid / NXCD; wgid = (xcd < r ? xcd * (q + 1) : r * (q + 1) + (xcd - r) * q) + off; }
        const int nig = WGM * nN, gid = wgid / nig, fm = gid * WGM, gsz = (nM - fm) < WGM ? (nM - fm) : WGM;
        u.pm = fm + ((wgid % nig) % gsz); u.pn = (wgid % nig) / gsz; return true;
    }
    __device__ __forceinline__ void a_ready(const Unit&) const {}
    __device__ __forceinline__ void done(const Unit&) const {}
};

typedef float f32x2_cv __attribute__((ext_vector_type(2))); typedef __bf16 bf16x2_cv __attribute__((ext_vector_type(2)));
__device__ __forceinline__ unsigned cvt_pk_bf16(float lo, float hi) { f32x2_cv v = {lo, hi}; bf16x2_cv b = __builtin_convertvector(v, bf16x2_cv); return __builtin_bit_cast(unsigned, b); }
__device__ __forceinline__ u32x4 pack8(f32x4 a, f32x4 b) { u32x4 w; w.x = cvt_pk_bf16(a[0], a[1]); w.y = cvt_pk_bf16(a[2], a[3]); w.z = cvt_pk_bf16(b[0], b[1]); w.w = cvt_pk_bf16(b[2], b[3]); return w; }
__device__ __forceinline__ void unpack8(u32x4 w, f32x4& a, f32x4& b) {
    a[0] = __uint_as_float(w.x << 16); a[1] = __uint_as_float(w.x & 0xffff0000u); a[2] = __uint_as_float(w.y << 16); a[3] = __uint_as_float(w.y & 0xffff0000u);
    b[0] = __uint_as_float(w.z << 16); b[1] = __uint_as_float(w.z & 0xffff0000u); b[2] = __uint_as_float(w.w << 16); b[3] = __uint_as_float(w.w & 0xffff0000u); }
#define EPI_LOOP_AM _Pragma("unroll") for (int ai = 0; ai < 2; ++ai) _Pragma("unroll") for (int m = 0; m < 4; ++m)
#define EPI_ROW (u.pm * BM + ai * HALF + wr * 64 + m * 16 + fr)
#define EPI_COL(bj) (u.pn * BM + (bj) * HALF + wc * 32 + 8 * fq)

struct EpiBf16 { static constexpr bool PERM = true, AFTER_DRAIN = false; bf16_t* O0; bf16_t* O1; int ldc;
    __device__ __forceinline__ void operator()(const f32x4 (&acc)[2][2][4][2], const Unit& u, int wr, int wc, int fr, int fq) const {
        bf16_t* O = u.pm < 3 ? O0 : O1 - (size_t)768 * ldc;
        EPI_LOOP_AM { const size_t row = EPI_ROW;
#pragma unroll
            for (int bj = 0; bj < 2; ++bj) *(u32x4*)(O + row * ldc + EPI_COL(bj)) = pack8(acc[ai][bj][m][0], acc[ai][bj][m][1]); } }
};
struct EpiProj { static constexpr bool PERM = true, AFTER_DRAIN = false;
    bf16_t *QA, *KA, *QB, *KB, *QI, *KIWI; const float* cs;
    __device__ __forceinline__ void operator()(const f32x4 (&acc)[2][2][4][2], const Unit& u, int wr, int wc, int fr, int fq) const {
        const int pn = u.pn; bf16_t* dst; int ldc, colt; float sc = 1.f;
        if (pn < 3) { dst = QA; ldc = 768; colt = 256 * pn; sc = C2; } else if (pn < 6) { dst = KA; ldc = 768; colt = 256 * (pn - 3); }
        else if (pn < 9) { dst = QB; ldc = 768; colt = 256 * (pn - 6); sc = C2; } else if (pn < 12) { dst = KB; ldc = 768; colt = 256 * (pn - 9); }
        else if (pn < 14) { dst = QI; ldc = 512; colt = 256 * (pn - 12); } else { dst = KIWI; ldc = 128; colt = 0; }
        const bool last = pn == 14, ropeLane = ((wc & 1) == 0) && fq < 2; const float sgn = fq == 0 ? -1.f : 1.f;
        EPI_LOOP_AM { const size_t row = EPI_ROW;
            f32x4 c0 = {0, 0, 0, 0}, c1 = c0, s0 = c0, s1 = c0;
            if (ropeLane) { const f32x4* p = (const f32x4*)(cs + row * 16); c0 = p[0]; c1 = p[1]; s0 = p[2]; s1 = p[3]; }
#pragma unroll
            for (int bj = 0; bj < 2; ++bj) { f32x4 v0 = acc[ai][bj][m][0], v1 = acc[ai][bj][m][1], p0, p1;
#pragma unroll
                for (int k = 0; k < 4; ++k) { p0[k] = __shfl_xor(v0[k], 16); p1[k] = __shfl_xor(v1[k], 16); }
                const bool doRope = ropeLane && (!last || (bj == 0 && wc == 0));
                if (doRope) { v0 = v0 * c0 + (sgn * p0) * s0; v1 = v1 * c1 + (sgn * p1) * s1; }
                v0 = v0 * sc; v1 = v1 * sc;
                if (!last || bj == 0) *(u32x4*)(dst + row * ldc + colt + bj * HALF + wc * 32 + 8 * fq) = pack8(v0, v1); } } }
};
struct EpiGate { static constexpr bool PERM = true, AFTER_DRAIN = false; bf16_t* O; int ldc; const float* bias;
    __device__ __forceinline__ void operator()(const f32x4 (&acc)[2][2][4][2], const Unit& u, int wr, int wc, int fr, int fq) const {
        f32x4 bv[2][2];
#pragma unroll
        for (int bj = 0; bj < 2; ++bj) { bv[bj][0] = *(const f32x4*)(bias + EPI_COL(bj)); bv[bj][1] = *(const f32x4*)(bias + EPI_COL(bj) + 4); }
        EPI_LOOP_AM { const size_t row = EPI_ROW;
#pragma unroll
            for (int bj = 0; bj < 2; ++bj) { f32x4 v[2];
#pragma unroll
                for (int n = 0; n < 2; ++n) { const f32x4 x = acc[ai][bj][m][n] + bv[bj][n];
#pragma unroll
                    for (int k = 0; k < 4; ++k) v[n][k] = __builtin_amdgcn_rcpf(1.f + __expf(-x[k])); }
                *(u32x4*)(O + row * ldc + EPI_COL(bj)) = pack8(v[0], v[1]); } } }
};
struct EpiBrA { static constexpr bool PERM = true, AFTER_DRAIN = false; float* T; const bf16_t* G;
    __device__ __forceinline__ void operator()(const f32x4 (&acc)[2][2][4][2], const Unit& u, int wr, int wc, int fr, int fq) const {
        EPI_LOOP_AM { const size_t row = EPI_ROW;
#pragma unroll
            for (int bj = 0; bj < 2; ++bj) { const int col = EPI_COL(bj); f32x4 g0, g1; unpack8(*(const u32x4*)(G + row * 2048 + col), g0, g1);
                *(f32x4*)(T + row * 1024 + col) = g0 * acc[ai][bj][m][0]; *(f32x4*)(T + row * 1024 + col + 4) = g1 * acc[ai][bj][m][1]; } } }
};
struct EpiBrB { static constexpr bool PERM = true, AFTER_DRAIN = false; const float* T; const bf16_t* G; bf16_t* O;
    __device__ __forceinline__ void operator()(const f32x4 (&acc)[2][2][4][2], const Unit& u, int wr, int wc, int fr, int fq) const {
        EPI_LOOP_AM { const size_t row = EPI_ROW;
#pragma unroll
            for (int bj = 0; bj < 2; ++bj) { const int col = EPI_COL(bj); f32x4 g0, g1; unpack8(*(const u32x4*)(G + row * 2048 + 1024 + col), g0, g1);
                const f32x4 t0 = *(const f32x4*)(T + row * 1024 + col), t1 = *(const f32x4*)(T + row * 1024 + col + 4);
                *(u32x4*)(O + row * 1024 + col) = pack8(t0 + g0 * acc[ai][bj][m][0], t1 + g1 * acc[ai][bj][m][1]); } } }
};
struct EpiRes { static constexpr bool PERM = true, AFTER_DRAIN = false; const float* R; float* Z;
    __device__ __forceinline__ void operator()(const f32x4 (&acc)[2][2][4][2], const Unit& u, int wr, int wc, int fr, int fq) const {
        EPI_LOOP_AM { const size_t row = EPI_ROW;
#pragma unroll
            for (int bj = 0; bj < 2; ++bj) { const int col = EPI_COL(bj);
                const f32x4 r0 = *(const f32x4*)(R + row * 1024 + col), r1 = *(const f32x4*)(R + row * 1024 + col + 4);
                *(f32x4*)(Z + row * 1024 + col) = r0 * DN_ALPHA + acc[ai][bj][m][0]; *(f32x4*)(Z + row * 1024 + col + 4) = r1 * DN_ALPHA + acc[ai][bj][m][1]; } } }
};
struct EpiSwiGLU { static constexpr bool PERM = true, AFTER_DRAIN = false; bf16_t* H;
    __device__ __forceinline__ void operator()(const f32x4 (&acc)[2][2][4][2], const Unit& u, int wr, int wc, int fr, int fq) const {
        EPI_LOOP_AM { const size_t row = EPI_ROW; f32x4 v[2];
#pragma unroll
            for (int n = 0; n < 2; ++n) { const f32x4 g = acc[ai][0][m][n], up = acc[ai][1][m][n];
#pragma unroll
                for (int k = 0; k < 4; ++k) v[n][k] = g[k] * __builtin_amdgcn_rcpf(1.f + __expf(-g[k])) * up[k]; }
            *(u32x4*)(H + row * 2816 + u.pn * HALF + wc * 32 + 8 * fq) = pack8(v[0], v[1]); } }
};
template <class Epi, class Sched, bool ALIGN_EPI = false, bool SP2 = false>
__device__ __forceinline__ void gemm_phase(PG8_LAS unsigned char* lds, const Gemm g, const Sched& S, const Epi& E) {
    const int tid = threadIdx.x, wid = __builtin_amdgcn_readfirstlane(tid >> 6), lane = tid & 63, wr = wid >> 2, wc = wid & 3, fr = lane & 15, fq = lane >> 4;
    const int K = g.K, nt = K / BK;
    unsigned voffA[2], voffB[2];
#pragma unroll
    for (int i = 0; i < 2; ++i) { int R, C; stage_rc(tid * 16 + i * 8192, R, C); const int Rb = Epi::PERM ? ((R & ~31) + perm32(R & 31)) : R;
        voffA[i] = (unsigned)(R * K + C) * 2u; voffB[i] = (unsigned)(Rb * K + C) * 2u; }
    const size_t kstep = (size_t)(BK * 2);
    const size_t hstep = (size_t)HALF * K * 2;
    const size_t tstep = 2 * hstep;
    const unsigned ldsw = (unsigned)wid * 1024u;
    const int aoff = lds_byte(wr * 64 + fr, fq * 8), boff = lds_byte(wc * 32 + fr, fq * 8);
#define PG8_SA(b, h) (((b) * 2 + (h)) * HTB)
#define PG8_SB(b, h) ((4 + (b) * 2 + (h)) * HTB)
#define PG8_STAGE(bufoff, gbase, voff) do { _Pragma("unroll") for (int _i = 0; _i < 2; ++_i) \
        __builtin_amdgcn_global_load_lds((const unsigned*)((const char*)(gbase) + (voff)[_i]), (PG8_LAS unsigned*)(lds + (bufoff) + ldsw + _i * 8192), 16, 0, 0); } while (0)
#define PG8_LDA(dst, b, h) do { _Pragma("unroll") for (int m = 0; m < 4; ++m) _Pragma("unroll") for (int k = 0; k < 2; ++k) dst[m][k] = *(const PG8_LAS bf16x8*)(lds + PG8_SA(b, h) + aoff + m * 2048 + k * 1024); } while (0)
#define PG8_LDB(dst, b, h) do { _Pragma("unroll") for (int n = 0; n < 2; ++n) _Pragma("unroll") for (int k = 0; k < 2; ++k) dst[n][k] = *(const PG8_LAS bf16x8*)(lds + PG8_SB(b, h) + boff + n * 2048 + k * 1024); } while (0)
#define PG8_MMA(ai, bj, At, Bt) do { __builtin_amdgcn_s_setprio(1); _Pragma("unroll") for (int m = 0; m < 4; ++m) _Pragma("unroll") for (int n = 0; n < 2; ++n) _Pragma("unroll") for (int k = 0; k < 2; ++k) \
        acc[ai][bj][m][n] = __builtin_amdgcn_mfma_f32_16x16x32_bf16(Bt[n][k], At[m][k], acc[ai][bj][m][n], 0, 0, 0); __builtin_amdgcn_s_setprio(0); } while (0)
#define PG8_WAIT_V(n) asm volatile("s_waitcnt vmcnt(" #n ")" ::: "memory")
#define PG8_WAIT_L(n) asm volatile("s_waitcnt lgkmcnt(" #n ")" ::: "memory")
#define PG8_BAR __builtin_amdgcn_s_barrier()
#define PG8_SCHED __builtin_amdgcn_sched_barrier(0)
    Unit cur, nxt; int ui = 0;
    if (!S.next(0, cur)) return;
    f32x4 acc[2][2][4][2];
#pragma unroll
    for (int a = 0; a < 2; ++a)
#pragma unroll
        for (int b = 0; b < 2; ++b)
#pragma unroll
            for (int m = 0; m < 4; ++m)
#pragma unroll
                for (int n = 0; n < 2; ++n) acc[a][b][m][n] = (f32x4){0.f, 0.f, 0.f, 0.f};
    bf16x8 At[4][2], B0[2][2], B1[2][2];
    const char* cA = (const char*)g.A + (size_t)cur.pm * tstep; const char* cB = (const char*)g.Bt + (size_t)cur.pn * tstep;
    S.a_ready(cur);
    if constexpr (SP2) {
        PG8_STAGE(PG8_SB(0, 0), cB, voffB); PG8_STAGE(PG8_SB(0, 1), cB + hstep, voffB); PG8_STAGE(PG8_SA(0, 0), cA, voffA); PG8_STAGE(PG8_SA(0, 1), cA + hstep, voffA);
        if (wr == 1) PG8_BAR;
        PG8_WAIT_V(2); PG8_BAR;
        PG8_STAGE(PG8_SB(1, 0), cB + kstep, voffB); PG8_STAGE(PG8_SA(1, 0), cA + kstep, voffA); PG8_STAGE(PG8_SB(1, 1), cB + hstep + kstep, voffB);
        PG8_WAIT_V(6); PG8_BAR;
    } else {
        PG8_STAGE(PG8_SB(0, 0), cB, voffB); PG8_STAGE(PG8_SA(0, 0), cA, voffA); PG8_STAGE(PG8_SB(0, 1), cB + hstep, voffB); PG8_STAGE(PG8_SA(0, 1), cA + hstep, voffA);
        if (wr == 1) PG8_BAR;
        PG8_WAIT_V(4); PG8_BAR;
        PG8_STAGE(PG8_SB(1, 0), cB + kstep, voffB); PG8_STAGE(PG8_SA(1, 0), cA + kstep, voffA); PG8_STAGE(PG8_SB(1, 1), cB + hstep + kstep, voffB);
        PG8_WAIT_V(6); PG8_BAR;
    }
    for (;;) {
        const bool has_next = S.next(ui + 1, nxt);
        const char* nA = has_next ? (const char*)g.A + (size_t)nxt.pm * tstep : cA; const char* nB = has_next ? (const char*)g.Bt + (size_t)nxt.pn * tstep : cB;
        for (int t = 0; t < nt; t += 2) {
            const bool last = (t == nt - 2);
            const char* a1 = cA + (size_t)(t + 1) * kstep;
            const char* a2 = last ? nA : cA + (size_t)(t + 2) * kstep; const char* b2 = last ? nB : cB + (size_t)(t + 2) * kstep;
            const char* a3 = a2 + kstep; const char* b3 = b2 + kstep;
            if (last && has_next) S.a_ready(nxt);
            if constexpr (SP2) {
            PG8_LDB(B0, 0, 0); PG8_LDB(B1, 0, 1); PG8_SCHED; PG8_LDA(At, 0, 0); PG8_STAGE(PG8_SA(1, 1), a1 + hstep, voffA);
            PG8_WAIT_V(8); PG8_WAIT_L(0); PG8_BAR; PG8_MMA(0, 0, At, B0); PG8_MMA(0, 1, At, B1); PG8_BAR; PG8_SCHED;
            PG8_LDA(At, 0, 1); PG8_STAGE(PG8_SB(0, 0), b2, voffB); PG8_STAGE(PG8_SB(0, 1), b2 + hstep, voffB); PG8_STAGE(PG8_SA(0, 0), a2, voffA);
            PG8_WAIT_V(8); PG8_WAIT_L(0); PG8_BAR; PG8_MMA(1, 0, At, B0); PG8_MMA(1, 1, At, B1); PG8_BAR; PG8_SCHED;
            PG8_LDB(B0, 1, 0); PG8_LDB(B1, 1, 1); PG8_SCHED; PG8_LDA(At, 1, 0); PG8_STAGE(PG8_SA(0, 1), a2 + hstep, voffA);
            PG8_WAIT_V(8); PG8_WAIT_L(0); PG8_BAR; PG8_MMA(0, 0, At, B0); PG8_MMA(0, 1, At, B1); PG8_BAR; PG8_SCHED;
            PG8_LDA(At, 1, 1); PG8_STAGE(PG8_SB(1, 0), b3, voffB); PG8_STAGE(PG8_SB(1, 1), b3 + hstep, voffB); PG8_STAGE(PG8_SA(1, 0), a3, voffA);
            PG8_WAIT_V(8); PG8_WAIT_L(0); PG8_BAR; PG8_MMA(1, 0, At, B0); PG8_MMA(1, 1, At, B1); PG8_BAR; PG8_SCHED;
            } else {
            PG8_LDB(B0, 0, 0); PG8_SCHED; PG8_LDA(At, 0, 0); PG8_STAGE(PG8_SA(1, 1), a1 + hstep, voffA);
            PG8_WAIT_L(8); PG8_BAR; PG8_WAIT_L(0); PG8_MMA(0, 0, At, B0); PG8_BAR; PG8_SCHED;
            PG8_LDB(B1, 0, 1); PG8_STAGE(PG8_SB(0, 0), b2, voffB);
            PG8_BAR; PG8_WAIT_L(0); PG8_MMA(0, 1, At, B1); PG8_BAR;
            PG8_LDA(At, 0, 1); PG8_STAGE(PG8_SA(0, 0), a2, voffA);
            PG8_BAR; PG8_WAIT_L(0); PG8_MMA(1, 0, At, B0); PG8_BAR; PG8_SCHED;
            PG8_STAGE(PG8_SB(0, 1), b2 + hstep, voffB);
            PG8_WAIT_V(6); PG8_BAR; PG8_MMA(1, 1, At, B1); PG8_BAR;
            PG8_LDB(B0, 1, 0); PG8_SCHED; PG8_LDA(At, 1, 0); PG8_STAGE(PG8_SA(0, 1), a2 + hstep, voffA);
            PG8_WAIT_L(8); PG8_BAR; PG8_WAIT_L(0); PG8_MMA(0, 0, At, B0); PG8_BAR; PG8_SCHED;
            PG8_LDB(B1, 1, 1); PG8_STAGE(PG8_SB(1, 0), b3, voffB);
            PG8_BAR; PG8_WAIT_L(0); PG8_MMA(0, 1, At, B1); PG8_BAR;
            PG8_LDA(At, 1, 1); PG8_STAGE(PG8_SA(1, 0), a3, voffA);
            PG8_BAR; PG8_WAIT_L(0); PG8_MMA(1, 0, At, B0); PG8_BAR; PG8_SCHED;
            PG8_STAGE(PG8_SB(1, 1), b3 + hstep, voffB);
            PG8_WAIT_V(6); PG8_BAR; PG8_MMA(1, 1, At, B1); PG8_BAR;
            }
        }
        if constexpr (ALIGN_EPI) { if (wr == 0) PG8_BAR; }
        if constexpr (!Epi::AFTER_DRAIN) { E(acc, cur, wr, wc, fr, fq); S.done(cur); }
        if (!has_next) break;
#pragma unroll
        for (int a = 0; a < 2; ++a)
#pragma unroll
            for (int b = 0; b < 2; ++b)
#pragma unroll
                for (int m = 0; m < 4; ++m)
#pragma unroll
                    for (int n = 0; n < 2; ++n) acc[a][b][m][n] = (f32x4){0.f, 0.f, 0.f, 0.f};
        cur = nxt; cA = nA; cB = nB; ++ui;
        if constexpr (ALIGN_EPI) { if (wr == 1) PG8_BAR; }
    }
    PG8_WAIT_V(0);
    if constexpr (!ALIGN_EPI) { if (wr == 0) PG8_BAR; }
    PG8_BAR;
    if constexpr (Epi::AFTER_DRAIN) { E.fused(acc, cur, wr, wc, fr, fq, lds, wid, lane); S.done(cur); }
#undef PG8_SA
#undef PG8_SB
#undef PG8_STAGE
#undef PG8_LDA
#undef PG8_LDB
#undef PG8_MMA
#undef PG8_WAIT_V
#undef PG8_WAIT_L
#undef PG8_BAR
#undef PG8_SCHED
}
}
#define LAS __attribute__((address_space(3)))
typedef unsigned short bf16;
typedef short bf16x8 __attribute__((ext_vector_type(8)));
typedef float f32x4 __attribute__((ext_vector_type(4)));
typedef float f32x16 __attribute__((ext_vector_type(16)));
typedef unsigned u32x4 __attribute__((ext_vector_type(4)));
typedef unsigned u32x2 __attribute__((ext_vector_type(2)));
typedef unsigned long long u64;
constexpr int NWAVES = 8, NTHR = 512;
constexpr int BATCH = 8, SEQ = 4096, DM = 1024, M = BATCH * SEQ, FFN = 2816;
constexpr int NPROJ = 3840, NVT = 1536, NGATE = 2048, NGU = 5632;
constexpr size_t MiB = 1u << 20;
constexpr size_t WS_CTL = 0;
constexpr size_t WS_WIN = 1 * MiB, WS_WV = WS_WIN + (size_t)NPROJ * DM * 2, WS_WGATE = WS_WV + (size_t)NVT * DM * 2, WS_WA = WS_WGATE + (size_t)NGATE * DM * 2,
                 WS_WB = WS_WA + (size_t)DM * 768 * 2, WS_WO = WS_WB + (size_t)DM * 256 * 2, WS_WGU = WS_WO + (size_t)DM * DM * 2, WS_WD = WS_WGU + (size_t)NGU * DM * 2,
                 WS_WEND = WS_WD + (size_t)DM * FFN * 2;
static_assert(WS_WEND <= 36 * MiB, "weights");
constexpr size_t WS_CS = 36 * MiB, WS_MASK = 38 * MiB, WS_XB = 54 * MiB, WS_QA = 118 * MiB, WS_KA = 166 * MiB, WS_VAT = 214 * MiB, WS_QB = 262 * MiB, WS_KB = 310 * MiB,
                 WS_VBT = 358 * MiB, WS_QI = 406 * MiB, WS_KIWI = 438 * MiB, WS_LSE = 446 * MiB, WS_OBC = 448 * MiB, WS_END = 464 * MiB;
constexpr size_t WS_GATE = 310 * MiB  , WS_MIXED = 166 * MiB  , WS_X1B = 54 * MiB  , WS_H = 118 * MiB  ;
static_assert(WS_H + (size_t)M * FFN * 2 <= WS_GATE + 128 * MiB, "map");
constexpr int LDS_BYTES = 147456;
constexpr int SCP = 4128;

__device__ __forceinline__ unsigned f2bf(float f) { unsigned u = __builtin_bit_cast(unsigned, f); return (u + 0x7fffu + ((u >> 16) & 1u)) >> 16; }
__device__ __forceinline__ unsigned pk2(float lo, float hi) { return f2bf(lo) | (f2bf(hi) << 16); }
__device__ __forceinline__ float bf_lo(unsigned w) { return __uint_as_float(w << 16); }
__device__ __forceinline__ float bf_hi(unsigned w) { return __uint_as_float(w & 0xffff0000u); }
__device__ __forceinline__ float wave_sum(float v) {
#pragma unroll
    for (int o = 1; o < 64; o <<= 1) v += __shfl_xor(v, o);
    return v; }

struct Args { const float* in[14]; float* out; unsigned char* ws; int ph_lo, ph_hi; };

__device__ __forceinline__ void tr_item(const float* W, int ld, int K, int c0, int nvalid, bf16* WT, int r0, int k0, LAS float* scr, int lane) {
    float tv[32];
#pragma unroll
    for (int i = 0; i < 32; ++i) { const int kk = 2 * i + (lane >> 5), n = lane & 31; tv[i] = (n < nvalid) ? W[(size_t)(k0 + kk) * ld + c0 + n] : 0.f; }
#pragma unroll
    for (int i = 0; i < 32; ++i) { const int kk = 2 * i + (lane >> 5), n = lane & 31; scr[kk * 33 + n] = tv[i]; }
    asm volatile("s_waitcnt lgkmcnt(0)" ::: "memory");
    const int c = lane & 7;
#pragma unroll
    for (int j = 0; j < 4; ++j) { const int n = (lane >> 3) + 8 * j; const LAS float* s = scr + (8 * c) * 33 + n;
        u32x4 o; o.x = pk2(s[0 * 33], s[1 * 33]); o.y = pk2(s[2 * 33], s[3 * 33]); o.z = pk2(s[4 * 33], s[5 * 33]); o.w = pk2(s[6 * 33], s[7 * 33]);
        *(u32x4*)(WT + (size_t)(r0 + n) * K + k0 + 8 * c) = o; }
    asm volatile("s_waitcnt lgkmcnt(0)" ::: "memory");
}
__device__ __forceinline__ void p0_prologue(const Args& a, LAS unsigned char* lds, int gw, int NGW, int wave, int lane) {
    unsigned char* ws = a.ws;
    LAS float* scr = (LAS float*)(lds + wave * 16384);
    const float* w_in = a.in[2];
    int it = gw;
    for (;; it += NGW) {
        int r = it; const float* src; int ld, K, col0, ncols, row0, mode = 0; bf16* dst;
#define SEC(S, LD, KK, C0, NC, DST, R0, MODE) { const int n_ = ((KK) / 64) * (((NC) + 31) / 32); if (r < n_) { src = (S); ld = (LD); K = (KK); col0 = (C0); ncols = (NC); dst = (bf16*)(ws + (DST)); row0 = (R0); mode = (MODE); goto found; } r -= n_; }
        SEC(w_in, 7240, 1024, 0, 768, WS_WIN, 0, 0)
        SEC(w_in, 7240, 1024, 768, 768, WS_WIN, 768, 0)
        SEC(w_in, 7240, 1024, 1536, 768, WS_WV, 0, 0)
        SEC(w_in, 7240, 1024, 2304, 768, WS_WIN, 1536, 0)
        SEC(w_in, 7240, 1024, 3072, 768, WS_WIN, 2304, 0)
        SEC(w_in, 7240, 1024, 3840, 768, WS_WV, 768, 0)
        SEC(w_in, 7240, 1024, 4608, 512, WS_WIN, 3072, 0)
        SEC(w_in, 7240, 1024, 5120, 64, WS_WIN, 3584, 0)
        SEC(w_in, 7240, 1024, 5184, 8, WS_WIN, 3648, 0)
        SEC(w_in, 7240, 1024, 5192, 2048, WS_WGATE, 0, 0)
        SEC(a.in[4], 1024, 768, 0, 1024, WS_WA, 0, 0)
        SEC(a.in[5], 1024, 256, 0, 1024, WS_WB, 0, 0)
        SEC(a.in[6], 1024, 1024, 0, 1024, WS_WO, 0, 0)
        SEC(a.in[9], 2816, 1024, 0, 2816, WS_WGU, 0, 1)
        SEC(a.in[10], 2816, 1024, 0, 2816, WS_WGU, 128, 1)
        SEC(a.in[11], 1024, 2816, 0, 1024, WS_WD, 0, 0)
#undef SEC
        break;
    found:;
        const int nblk = (ncols + 31) / 32, kb = r / nblk, nb = r % nblk, n0 = 32 * nb;
        const int nvalid = (ncols - n0) < 32 ? (ncols - n0) : 32;
        const int r0 = row0 + (mode ? 256 * (n0 / 128) + (n0 % 128) : n0);
        tr_item(src, ld, K, col0 + n0, nvalid, dst, r0, 64 * kb, scr, lane);
    }
    { u32x4* p = (u32x4*)(ws + WS_WIN + (size_t)3680 * DM * 2); const int n16 = 160 * DM * 2 / 16;
      for (int i = gw * 64 + lane; i < n16; i += NGW * 64) p[i] = (u32x4){0u, 0u, 0u, 0u}; }
    { const f32x4* x4 = (const f32x4*)a.in[0]; u32x4* xb = (u32x4*)(ws + WS_XB); const int n8 = M * DM / 8; const int stride = NGW * 64;
      for (int i = gw * 64 + lane; i < n8; i += 4 * stride) { f32x4 p[4], q[4];
#pragma unroll
          for (int u = 0; u < 4; ++u) { const int ii = i + u * stride; if (ii < n8) { p[u] = x4[2 * ii]; q[u] = x4[2 * ii + 1]; } }
#pragma unroll
          for (int u = 0; u < 4; ++u) { const int ii = i + u * stride; if (ii < n8) { u32x4 o; o.x = pk2(p[u][0], p[u][1]); o.y = pk2(p[u][2], p[u][3]); o.z = pk2(q[u][0], q[u][1]); o.w = pk2(q[u][2], q[u][3]); xb[ii] = o; } } } }
    { const int* pos = (const int*)a.in[1]; float* cs = (float*)(ws + WS_CS);
      for (int i = gw * 64 + lane; i < M * 8; i += NGW * 64) { const int row = i >> 3, f = i & 7;
          const float inv = powf(500000.0f, -(float)(2 * f) / 16.0f); const float ang = (float)pos[row] * inv;
          cs[row * 16 + f] = cosf(ang); cs[row * 16 + 8 + f] = sinf(ang); } }
}

#define WRL(dst, sval, ln) asm volatile("s_nop 4\n\tv_writelane_b32 %0, %1, %2\n\ts_nop 1" : "+v"(dst) : "s"(sval), "i"(ln))
__device__ __forceinline__ void indexer_phase(LAS unsigned char* lds, const bf16* QI, const bf16* KIWI, u64* MASK, int blk, int nblk, int wid, int lane) {
    LAS float* sc = (LAS float*)lds;
    const int m = lane & 31, kh = lane >> 5;
    for (int u = blk; u < BATCH * (SEQ / 8); u += nblk) {
        const int b = u & 7, t0 = (u >> 3) * 8;
        const size_t rb = (size_t)b * SEQ;
        {
            const int qloc = 2 * ((m >> 2) & 1) + ((m >> 4) & 1), head = 4 * ((m >> 3) & 1) + (m & 3);
            bf16x8 qf[2][4]; float wv[2][2][8];
#pragma unroll
            for (int r2 = 0; r2 < 2; ++r2) { const bf16* qp = QI + (rb + t0 + 4 * r2 + qloc) * 512 + head * 64 + 8 * kh;
#pragma unroll
                for (int kk = 0; kk < 4; ++kk) qf[r2][kk] = *(const bf16x8*)(qp + 16 * kk);
#pragma unroll
                for (int i = 0; i < 2; ++i) { const u32x4 w = *(const u32x4*)(KIWI + (rb + t0 + 4 * r2 + 2 * kh + i) * 128 + 64);
                    wv[r2][i][0] = bf_lo(w.x); wv[r2][i][1] = bf_hi(w.x); wv[r2][i][2] = bf_lo(w.y); wv[r2][i][3] = bf_hi(w.y); wv[r2][i][4] = bf_lo(w.z); wv[r2][i][5] = bf_hi(w.z); wv[r2][i][6] = bf_lo(w.w); wv[r2][i][7] = bf_hi(w.w); } }
            const int nkt = (t0 + 7) / 32 + 1;
            const bf16* kbase = KIWI + (rb + m) * 128 + 8 * kh;
#define LOADK(buf, KT) do { if ((KT) < nkt) { const bf16* kp_ = kbase + (size_t)(KT) * 32 * 128; _Pragma("unroll") for (int kk = 0; kk < 4; ++kk) buf[kk] = *(const bf16x8*)(kp_ + 16 * kk); } } while (0)
#define COMPK(buf, KT) do { if ((KT) < nkt) { const int key = 32 * (KT) + m; \
                f32x16 a0 = {0, 0, 0, 0, 0, 0, 0, 0, 0, 0, 0, 0, 0, 0, 0, 0}, a1 = a0; \
                _Pragma("unroll") for (int kk = 0; kk < 4; ++kk) { a0 = __builtin_amdgcn_mfma_f32_32x32x16_bf16(qf[0][kk], buf[kk], a0, 0, 0, 0); a1 = __builtin_amdgcn_mfma_f32_32x32x16_bf16(qf[1][kk], buf[kk], a1, 0, 0, 0); } \
                _Pragma("unroll") for (int i = 0; i < 2; ++i) { float s0_ = 0.f, s1_ = 0.f; \
                    _Pragma("unroll") for (int h = 0; h < 8; ++h) { s0_ += wv[0][i][h] * fmaxf(a0[8 * i + h], 0.f); s1_ += wv[1][i][h] * fmaxf(a1[8 * i + h], 0.f); } \
                    sc[(2 * kh + i) * SCP + key] = s0_ + 0.0f; sc[(4 + 2 * kh + i) * SCP + key] = s1_ + 0.0f; } } } while (0)
            bf16x8 k0[4], k1[4], k2[4];
            int kt = wid;
            LOADK(k0, kt); LOADK(k1, kt + 8);
            for (; kt < nkt; kt += 24) {
                LOADK(k2, kt + 16); COMPK(k0, kt);
                LOADK(k0, kt + 24); COMPK(k1, kt + 8);
                LOADK(k1, kt + 32); COMPK(k2, kt + 16);
            }
#undef LOADK
#undef COMPK
        }
        __syncthreads();
        {
            const int t = t0 + wid, jmax = t >> 6;
            unsigned uv[64]; const int lim = t - lane;
#pragma unroll
            for (int j = 0; j < 64; ++j) { const unsigned bts = __float_as_uint(sc[wid * SCP + 64 * j + lane]);
                const unsigned s = bts ^ ((unsigned)((int)bts >> 31) | 0x80000000u); uv[j] = (64 * j <= lim) ? s : 0u; }
            unsigned mw_lo = 0u, mw_hi = 0u;
            u64 mm[8];
#define CMP8(OP, OFF, C) asm("v_cmp_" OP "_u32_e64 %0, %8, %16\n\tv_cmp_" OP "_u32_e64 %1, %9, %16\n\tv_cmp_" OP "_u32_e64 %2, %10, %16\n\tv_cmp_" OP "_u32_e64 %3, %11, %16\n\t" \
                "v_cmp_" OP "_u32_e64 %4, %12, %16\n\tv_cmp_" OP "_u32_e64 %5, %13, %16\n\tv_cmp_" OP "_u32_e64 %6, %14, %16\n\tv_cmp_" OP "_u32_e64 %7, %15, %16" \
                : "=&s"(mm[0]), "=&s"(mm[1]), "=&s"(mm[2]), "=&s"(mm[3]), "=&s"(mm[4]), "=&s"(mm[5]), "=&s"(mm[6]), "=&s"(mm[7]) \
                : "v"(uv[(OFF) + 0]), "v"(uv[(OFF) + 1]), "v"(uv[(OFF) + 2]), "v"(uv[(OFF) + 3]), "v"(uv[(OFF) + 4]), "v"(uv[(OFF) + 5]), "v"(uv[(OFF) + 6]), "v"(uv[(OFF) + 7]), "s"(C))
#define POP8() (__popcll(mm[0]) + __popcll(mm[1]) + __popcll(mm[2]) + __popcll(mm[3]) + __popcll(mm[4]) + __popcll(mm[5]) + __popcll(mm[6]) + __popcll(mm[7]))
#define WRL8(OFF) asm volatile("s_nop 4\n\tv_writelane_b32 %0, %2, %18\n\tv_writelane_b32 %1, %3, %18\n\tv_writelane_b32 %0, %4, %19\n\tv_writelane_b32 %1, %5, %19\n\t" \
                "v_writelane_b32 %0, %6, %20\n\tv_writelane_b32 %1, %7, %20\n\tv_writelane_b32 %0, %8, %21\n\tv_writelane_b32 %1, %9, %21\n\t" \
                "v_writelane_b32 %0, %10, %22\n\tv_writelane_b32 %1, %11, %22\n\tv_writelane_b32 %0, %12, %23\n\tv_writelane_b32 %1, %13, %23\n\t" \
                "v_writelane_b32 %0, %14, %24\n\tv_writelane_b32 %1, %15, %24\n\tv_writelane_b32 %0, %16, %25\n\tv_writelane_b32 %1, %17, %25\n\ts_nop 1" \
                : "+v"(mw_lo), "+v"(mw_hi) \
                : "s"((unsigned)mm[0]), "s"((unsigned)(mm[0] >> 32)), "s"((unsigned)mm[1]), "s"((unsigned)(mm[1] >> 32)), "s"((unsigned)mm[2]), "s"((unsigned)(mm[2] >> 32)), "s"((unsigned)mm[3]), "s"((unsigned)(mm[3] >> 32)), \
                  "s"((unsigned)mm[4]), "s"((unsigned)(mm[4] >> 32)), "s"((unsigned)mm[5]), "s"((unsigned)(mm[5] >> 32)), "s"((unsigned)mm[6]), "s"((unsigned)(mm[6] >> 32)), "s"((unsigned)mm[7]), "s"((unsigned)(mm[7] >> 32)), \
                  "i"((OFF) + 0), "i"((OFF) + 1), "i"((OFF) + 2), "i"((OFF) + 3), "i"((OFF) + 4), "i"((OFF) + 5), "i"((OFF) + 6), "i"((OFF) + 7))
            if (t < 256) {
#pragma unroll
                for (int j = 0; j < 4; ++j) { const u64 wd = __ballot(64 * j + lane <= t); WRL(mw_lo, (unsigned)wd, j); WRL(mw_hi, (unsigned)(wd >> 32), j); }
            } else {
                unsigned ustar = 0u; int cge = 0;
                for (int bit = 31; bit >= 0; --bit) { const unsigned cand = __builtin_amdgcn_readfirstlane(ustar | (1u << bit)); int cnt = 0;
#pragma unroll
                    for (int g = 0; g < 8; ++g) if (8 * g <= jmax) { CMP8("ge", 8 * g, cand); cnt += POP8(); }
                    if (cnt >= 256) { ustar = cand; cge = cnt; }
                    if (cnt == 256) break; }
                ustar = __builtin_amdgcn_readfirstlane(ustar);
                if (cge != 256) {
                    cge = 0;
#pragma unroll
                    for (int g = 0; g < 8; ++g) { CMP8("ge", 8 * g, ustar); cge += POP8(); } }
                if (cge == 256) {
#pragma unroll
                    for (int g = 0; g < 8; ++g) { CMP8("ge", 8 * g, ustar); WRL8(8 * g); }
                } else {
                    int cgt = 0;
#pragma unroll
                    for (int j = 0; j < 64; ++j) { cgt += __popcll(__ballot(uv[j] > ustar)); __builtin_amdgcn_sched_barrier(0); }
                    int remaining = 256 - cgt; asm volatile("" : "+s"(ustar));
#pragma unroll
                    for (int j = 0; j < 64; ++j) { const bool eq = uv[j] == ustar; const u64 em = __ballot(eq);
                        const int rank = __builtin_amdgcn_mbcnt_hi((unsigned)(em >> 32), __builtin_amdgcn_mbcnt_lo((unsigned)em, 0u));
                        const bool sel = (uv[j] > ustar) || (eq && rank < remaining); const int c = __popcll(em); remaining -= (c < remaining ? c : remaining);
                        const u64 wd = __ballot(sel); WRL(mw_lo, (unsigned)wd, j); WRL(mw_hi, (unsigned)(wd >> 32), j); __builtin_amdgcn_sched_barrier(0); }
                }
            }
#undef CMP8
#undef POP8
#undef WRL8
            MASK[(rb + t) * 64 + lane] = ((u64)mw_hi << 32) | (u64)mw_lo;
        }
        __syncthreads();
    }
}

__device__ __forceinline__ int pi32(int r) { return (r & 0x13) | ((r & 4) << 1) | ((r & 8) >> 1); }
__device__ __forceinline__ void attn_unit(LAS unsigned char* lds, const bf16* Q, const bf16* K, const bf16* VT, bf16* O, float* LSE, const u64* MASK,
                                          bool isB, int b, int h, int q0, int t_lo, int t_hi, int win, int dsh, int tid, int wid, int lane, bool dry = false) {
    const int ql = lane & 31, hi = lane >> 5;
    const size_t rb = (size_t)b * SEQ; const int tq = q0 + 32 * wid + ql; const size_t rowq = rb + tq;
    bf16x8 qf[4];
#pragma unroll
    for (int kk = 0; kk < 4; ++kk) qf[kk] = *(const bf16x8*)(Q + rowq * 768 + h * 64 + 16 * kk + 8 * hi);
    f32x16 o0 = {0, 0, 0, 0, 0, 0, 0, 0, 0, 0, 0, 0, 0, 0, 0, 0}, o1 = o0;
    float m_run = -1e30f, l_run = 0.f;
    const int sr = tid >> 3, scc = tid & 7;
    const bf16* ksrc = K + (rb + sr) * 768 + h * 64 + 8 * scc;
    const bf16* vsrc = VT + (size_t)(h * 64 + sr) * M + rb + 8 * scc;
    const int swoff = (sr * 72 + 8 * scc) * 2;
    const int kroff = (pi32(ql) * 72 + 8 * hi) * 2, vroff = 9216 + (ql * 72 + 8 * hi) * 2;
    const u64* mrow = MASK + rowq * 64;
    u32x4 kreg = *(const u32x4*)(ksrc + (size_t)64 * t_lo * 768), vreg = *(const u32x4*)(vsrc + 64 * t_lo);
    u64 mw_next = isB ? 0ull : mrow[t_lo];
    __syncthreads();
    *(LAS u32x4*)(lds + swoff) = kreg; *(LAS u32x4*)(lds + 9216 + swoff) = vreg;
    __syncthreads();
    const u64 pat = (dsh == 0 ? ~0ull : (dsh == 2 ? 0x1111111111111111ull : 0x0001000100010001ull)) << (tq & ((1 << dsh) - 1));
    for (int t = t_lo; t < t_hi; ++t) {
        const int cur = (t - t_lo) & 1; LAS unsigned char* buf = lds + cur * 18432;
        const bool more = (t + 1 < t_hi);
        if (more) { kreg = *(const u32x4*)(ksrc + (size_t)64 * (t + 1) * 768); vreg = *(const u32x4*)(vsrc + 64 * (t + 1)); }
        u64 mw;
        if (isB) { const int hi_i = tq - 64 * t, lo_i = hi_i - win;
            const u64 up = hi_i >= 63 ? ~0ull : (hi_i < 0 ? 0ull : ((2ull << hi_i) - 1ull)); const u64 lw = lo_i <= 0 ? ~0ull : (lo_i > 63 ? 0ull : (~0ull << lo_i));
            mw = pat & up & lw;
        } else { mw = mw_next; if (more) mw_next = mrow[t + 1]; }
        f32x16 s0 = {0, 0, 0, 0, 0, 0, 0, 0, 0, 0, 0, 0, 0, 0, 0, 0}, s1 = s0;
#pragma unroll
        for (int kk = 0; kk < 4; ++kk) { const bf16x8 a0 = *(const LAS bf16x8*)(buf + kroff + 32 * kk), a1 = *(const LAS bf16x8*)(buf + kroff + 32 * 144 + 32 * kk);
            s0 = __builtin_amdgcn_mfma_f32_32x32x16_bf16(a0, qf[kk], s0, 0, 0, 0); s1 = __builtin_amdgcn_mfma_f32_32x32x16_bf16(a1, qf[kk], s1, 0, 0, 0); }
        const unsigned m0 = (unsigned)(mw >> (8 * hi)), m1 = (unsigned)(mw >> (32 + 8 * hi));
        const unsigned NEGB = 0xF149F2CAu;
        float mx = -1e30f;
#pragma unroll
        for (int j = 0; j < 16; ++j) { const int bp = (j & 7) + 16 * (j >> 3);
            const unsigned k0 = (unsigned)__builtin_amdgcn_sbfe((int)m0, bp, 1), k1 = (unsigned)__builtin_amdgcn_sbfe((int)m1, bp, 1);
            s0[j] = __uint_as_float((__float_as_uint(s0[j]) & k0) | (NEGB & ~k0)); s1[j] = __uint_as_float((__float_as_uint(s1[j]) & k1) | (NEGB & ~k1));
            mx = fmaxf(mx, fmaxf(s0[j], s1[j])); }
        mx = fmaxf(mx, __shfl_xor(mx, 32));
        if (__any(mx > m_run)) { const float mn = fmaxf(m_run, mx); const float f = __builtin_amdgcn_exp2f(m_run - mn); m_run = mn; l_run *= f;
#pragma unroll
            for (int j = 0; j < 16; ++j) { o0[j] *= f; o1[j] *= f; } }
        float ps = 0.f;
#pragma unroll
        for (int j = 0; j < 16; ++j) { s0[j] = __builtin_amdgcn_exp2f(s0[j] - m_run); s1[j] = __builtin_amdgcn_exp2f(s1[j] - m_run); ps += s0[j] + s1[j]; }
        l_run += ps;
        bf16x8 pf[2][2];
#pragma unroll
        for (int k2 = 0; k2 < 2; ++k2) { u32x4 w0, w1;
            w0.x = pg8::cvt_pk_bf16(s0[8 * k2 + 0], s0[8 * k2 + 1]); w0.y = pg8::cvt_pk_bf16(s0[8 * k2 + 2], s0[8 * k2 + 3]); w0.z = pg8::cvt_pk_bf16(s0[8 * k2 + 4], s0[8 * k2 + 5]); w0.w = pg8::cvt_pk_bf16(s0[8 * k2 + 6], s0[8 * k2 + 7]);
            w1.x = pg8::cvt_pk_bf16(s1[8 * k2 + 0], s1[8 * k2 + 1]); w1.y = pg8::cvt_pk_bf16(s1[8 * k2 + 2], s1[8 * k2 + 3]); w1.z = pg8::cvt_pk_bf16(s1[8 * k2 + 4], s1[8 * k2 + 5]); w1.w = pg8::cvt_pk_bf16(s1[8 * k2 + 6], s1[8 * k2 + 7]);
            pf[0][k2] = __builtin_bit_cast(bf16x8, w0); pf[1][k2] = __builtin_bit_cast(bf16x8, w1); }
#pragma unroll
        for (int s = 0; s < 2; ++s)
#pragma unroll
            for (int k2 = 0; k2 < 2; ++k2) { const int co = (32 * s + 16 * k2) * 2;
                const bf16x8 v0 = *(const LAS bf16x8*)(buf + vroff + co), v1 = *(const LAS bf16x8*)(buf + vroff + 32 * 144 + co);
                o0 = __builtin_amdgcn_mfma_f32_32x32x16_bf16(v0, pf[s][k2], o0, 0, 0, 0); o1 = __builtin_amdgcn_mfma_f32_32x32x16_bf16(v1, pf[s][k2], o1, 0, 0, 0); }
        if (more) { LAS unsigned char* nb = lds + (cur ^ 1) * 18432; *(LAS u32x4*)(nb + swoff) = kreg; *(LAS u32x4*)(nb + 9216 + swoff) = vreg; }
        __syncthreads();
    }
    const float lt = l_run + __shfl_xor(l_run, 32); const float inv = 1.0f / lt;
    if (dry && lt > -1.f) return;
    bf16* op = O + rowq * 768 + h * 64 + 4 * hi;
#pragma unroll
    for (int jg = 0; jg < 4; ++jg) { u32x2 w;
        w.x = pk2(o0[4 * jg] * inv, o0[4 * jg + 1] * inv); w.y = pk2(o0[4 * jg + 2] * inv, o0[4 * jg + 3] * inv); *(u32x2*)(op + 8 * jg) = w;
        w.x = pk2(o1[4 * jg] * inv, o1[4 * jg + 1] * inv); w.y = pk2(o1[4 * jg + 2] * inv, o1[4 * jg + 3] * inv); *(u32x2*)(op + 32 + 8 * jg) = w; }
    if (isB && hi == 0) LSE[rowq * 12 + h] = 0.6931471805599453f * (m_run + log2f(lt));
}
__device__ __forceinline__ void attn_phase(LAS unsigned char* lds, unsigned char* ws, unsigned* ctr, int tid, int wid, int lane, bool dry = false) {
    LAS int* slot = (LAS int*)(lds + 40960);
    for (;;) {
        __syncthreads();
        if (tid == 0) *slot = (int)atomicAdd(ctr, 1u);
        __syncthreads();
        const int k = *slot;
        if (k >= 3072) break;
        if (k < 1536) { const int qb = 15 - k / 96, rem = k % 96, b = rem / 12, h = rem % 12;
            attn_unit(lds, (const bf16*)(ws + WS_QA), (const bf16*)(ws + WS_KA), (const bf16*)(ws + WS_VAT), (bf16*)(ws + WS_QA), nullptr, (const u64*)(ws + WS_MASK),
                      false, b, h, 256 * qb, 0, 4 * qb + 4, 0, 0, tid, wid, lane, dry);
        } else { const int k2 = k - 1536, gs = 2 - k2 / 512, r = k2 % 512, qb = 15 - r / 32, rem = r % 32, b = rem / 4, hg = rem % 4;
            const int win = gs == 0 ? 128 : (gs == 1 ? 512 : 2048), dsh = gs == 0 ? 0 : (gs == 1 ? 2 : 4);
            const int q0 = 256 * qb; const int lo = q0 - win; const int t_lo = lo > 0 ? lo / 64 : 0;
            attn_unit(lds, (const bf16*)(ws + WS_QB), (const bf16*)(ws + WS_KB), (const bf16*)(ws + WS_VBT), (bf16*)(ws + WS_QB), (float*)(ws + WS_LSE), nullptr,
                      true, b, gs * 4 + hg, q0, t_lo, 4 * qb + 4, win, dsh, tid, wid, lane, dry);
        }
    }
}

__device__ __forceinline__ void combine_b(unsigned char* ws, int gw, int NGW, int lane) {
    const bf16* OB = (const bf16*)(ws + WS_QB); const float* LSE = (const float*)(ws + WS_LSE); bf16* OBC = (bf16*)(ws + WS_OBC);
    for (int row = gw; row < M; row += NGW) { const int hg = lane >> 4, c = (lane & 15) * 4;
        const float l0 = LSE[(size_t)row * 12 + hg], l1 = LSE[(size_t)row * 12 + 4 + hg], l2 = LSE[(size_t)row * 12 + 8 + hg];
        const float mx = fmaxf(l0, fmaxf(l1, l2)); const float e0 = __expf(l0 - mx), e1 = __expf(l1 - mx), e2 = __expf(l2 - mx); const float inv = 1.f / (e0 + e1 + e2);
        const u32x2 a = *(const u32x2*)(OB + (size_t)row * 768 + hg * 64 + c), bb = *(const u32x2*)(OB + (size_t)row * 768 + 256 + hg * 64 + c), cc = *(const u32x2*)(OB + (size_t)row * 768 + 512 + hg * 64 + c);
        const float a0 = e0 * inv, a1 = e1 * inv, a2 = e2 * inv; u32x2 o;
        o.x = pk2(a0 * bf_lo(a.x) + a1 * bf_lo(bb.x) + a2 * bf_lo(cc.x), a0 * bf_hi(a.x) + a1 * bf_hi(bb.x) + a2 * bf_hi(cc.x));
        o.y = pk2(a0 * bf_lo(a.y) + a1 * bf_lo(bb.y) + a2 * bf_lo(cc.y), a0 * bf_hi(a.y) + a1 * bf_hi(bb.y) + a2 * bf_hi(cc.y));
        *(u32x2*)(OBC + (size_t)row * 256 + hg * 64 + c) = o; }
}
__device__ __forceinline__ void ln_rows(float* Z, const float* g, const float* bta, bf16* OB16, int gw, int NGW, int lane) {
    f32x4 gv[4], bv[4];
#pragma unroll
    for (int j = 0; j < 4; ++j) { gv[j] = ((const f32x4*)g)[lane + 64 * j]; bv[j] = ((const f32x4*)bta)[lane + 64 * j]; }
    for (int row0 = gw; row0 < M; row0 += 2 * NGW) {
        f32x4 v[2][4]; float s[2] = {0.f, 0.f}; f32x4* zr[2];
#pragma unroll
        for (int r = 0; r < 2; ++r) { const int row = row0 + r * NGW; zr[r] = (f32x4*)(Z + (size_t)(row < M ? row : row0) * DM) + lane;
#pragma unroll
            for (int j = 0; j < 4; ++j) v[r][j] = zr[r][64 * j]; }
#pragma unroll
        for (int r = 0; r < 2; ++r) {
#pragma unroll
            for (int j = 0; j < 4; ++j) s[r] += (v[r][j][0] + v[r][j][1]) + (v[r][j][2] + v[r][j][3]); }
        const float mean0 = wave_sum(s[0]) * (1.f / DM), mean1 = wave_sum(s[1]) * (1.f / DM); float s2[2] = {0.f, 0.f};
#pragma unroll
        for (int r = 0; r < 2; ++r) { const float mean = r ? mean1 : mean0;
#pragma unroll
            for (int j = 0; j < 4; ++j) { v[r][j] = v[r][j] - mean; s2[r] += (v[r][j][0] * v[r][j][0] + v[r][j][1] * v[r][j][1]) + (v[r][j][2] * v[r][j][2] + v[r][j][3] * v[r][j][3]); } }
        const float rs0 = 1.f / sqrtf(wave_sum(s2[0]) * (1.f / DM) + 1e-5f), rs1 = 1.f / sqrtf(wave_sum(s2[1]) * (1.f / DM) + 1e-5f);
#pragma unroll
        for (int r = 0; r < 2; ++r) { const int row = row0 + r * NGW; if (row < M) { const float rstd = r ? rs1 : rs0;
#pragma unroll
            for (int j = 0; j < 4; ++j) { const f32x4 y = v[r][j] * rstd * gv[j] + bv[j]; zr[r][64 * j] = y;
                if (OB16) { u32x2 w; w.x = pk2(y[0], y[1]); w.y = pk2(y[2], y[3]); *((u32x2*)(OB16 + (size_t)row * DM) + lane + 64 * j) = w; } } } }
    }
}

__global__ void __launch_bounds__(NTHR, 2) fwd_megakernel(Args args) {
    extern __shared__ __attribute__((aligned(16))) unsigned char lds_raw[];
    LAS unsigned char* lds = (LAS unsigned char*)lds_raw;
    const int tid = threadIdx.x, lane = tid & 63, wid = __builtin_amdgcn_readfirstlane(tid >> 6);
    const int G = gridDim.x, blk = blockIdx.x, gw = blk * NWAVES + wid, NGW = G * NWAVES;
    unsigned char* ws = args.ws;
    const int lo = args.ph_lo, hi = args.ph_hi;
#ifndef PH_MASK
#define PH_MASK 0xFFFF
#endif
#define IN(k) (((PH_MASK >> (k)) & 1) && lo <= (k) && (k) < hi)
#define SEAM(k) do { if (IN(k) && IN((k) + 1)) { cg::this_grid().sync(); } } while (0)
    using namespace pg8;
    if (IN(0)) { p0_prologue(args, lds, gw, NGW, wid, lane); }
    SEAM(0);
    if (IN(1)) {
        { Gemm g{(const bf16_t*)(ws + WS_XB), (const bf16_t*)(ws + WS_WIN), M, NPROJ, DM}; StaticOrder S; S.init(M, NPROJ, G, blk);
          EpiProj E{(bf16_t*)(ws + WS_QA), (bf16_t*)(ws + WS_KA), (bf16_t*)(ws + WS_QB), (bf16_t*)(ws + WS_KB), (bf16_t*)(ws + WS_QI), (bf16_t*)(ws + WS_KIWI), (const float*)(ws + WS_CS)};
          gemm_phase<EpiProj, StaticOrder, true, true>(lds, g, S, E); }
        { Gemm g{(const bf16_t*)(ws + WS_WV), (const bf16_t*)(ws + WS_XB), NVT, M, DM}; StaticOrder S; S.init(NVT, M, G, blk);
          EpiBf16 E{(bf16_t*)(ws + WS_VAT), (bf16_t*)(ws + WS_VBT), M};
          gemm_phase<EpiBf16, StaticOrder, true, true>(lds, g, S, E); }
    }
    SEAM(1);
    if (IN(2)) indexer_phase(lds, (const bf16*)(ws + WS_QI), (const bf16*)(ws + WS_KIWI), (u64*)(ws + WS_MASK), blk, G, wid, lane);
    SEAM(2);
#ifdef PROBE_ATT
    if (IN(3)) { attn_phase(lds, ws, (unsigned*)(ws + WS_CTL) + 128, tid, wid, lane, true); cg::this_grid().sync(); }
#endif
#ifdef PROBE_IDX
    if (IN(3)) { indexer_phase(lds, (const bf16*)(ws + WS_QI), (const bf16*)(ws + WS_KIWI), (u64*)(ws + WS_MASK), blk, G, wid, lane); cg::this_grid().sync(); }
#endif
    if (IN(3)) attn_phase(lds, ws, (unsigned*)(ws + WS_CTL) + 64, tid, wid, lane);
    SEAM(3);
    if (IN(4)) {
        combine_b(ws, gw, NGW, lane);
        Gemm g{(const bf16_t*)(ws + WS_XB), (const bf16_t*)(ws + WS_WGATE), M, NGATE, DM}; StaticOrder S; S.init(M, NGATE, G, blk);
        EpiGate E{(bf16_t*)(ws + WS_GATE), NGATE, args.in[3]};
        gemm_phase<EpiGate, StaticOrder, true, true>(lds, g, S, E);
    }
    SEAM(4);
    if (IN(5)) {
        { Gemm g{(const bf16_t*)(ws + WS_QA), (const bf16_t*)(ws + WS_WA), M, DM, 768}; StaticOrder S; S.init(M, DM, G, blk);
          EpiBrA E{args.out, (const bf16_t*)(ws + WS_GATE)};
          gemm_phase<EpiBrA, StaticOrder, true, true>(lds, g, S, E); }
        { Gemm g{(const bf16_t*)(ws + WS_OBC), (const bf16_t*)(ws + WS_WB), M, DM, 256}; StaticOrder S; S.init(M, DM, G, blk);
          EpiBrB E{args.out, (const bf16_t*)(ws + WS_GATE), (bf16_t*)(ws + WS_MIXED)};
          gemm_phase<EpiBrB, StaticOrder, true, true>(lds, g, S, E); }
    }
    SEAM(5);
    if (IN(6)) {
        Gemm g{(const bf16_t*)(ws + WS_MIXED), (const bf16_t*)(ws + WS_WO), M, DM, DM}; StaticOrder S; S.init(M, DM, G, blk);
        EpiRes E{args.in[0], args.out};
        gemm_phase<EpiRes, StaticOrder, true, true>(lds, g, S, E);
    }
    SEAM(6);
    if (IN(7)) ln_rows(args.out, args.in[7], args.in[8], (bf16*)(ws + WS_X1B), gw, NGW, lane);
    SEAM(7);
    if (IN(8)) {
        Gemm g{(const bf16_t*)(ws + WS_X1B), (const bf16_t*)(ws + WS_WGU), M, NGU, DM}; StaticOrder S; S.init(M, NGU, G, blk);
        EpiSwiGLU E{(bf16_t*)(ws + WS_H)};
        gemm_phase<EpiSwiGLU, StaticOrder, true, true>(lds, g, S, E);
    }
    SEAM(8);
    if (IN(9)) {
        Gemm g{(const bf16_t*)(ws + WS_H), (const bf16_t*)(ws + WS_WD), M, DM, FFN}; StaticOrder S; S.init(M, DM, G, blk);
        EpiRes E{args.out, args.out};
        gemm_phase<EpiRes, StaticOrder, true, true>(lds, g, S, E);
    }
    SEAM(9);
    if (IN(10)) ln_rows(args.out, args.in[12], args.in[13], nullptr, gw, NGW, lane);
#undef IN
#undef SEAM
}

constexpr int NPHASE = 11;
extern "C" void kernel_launch(void* const* d_in, const int* in_sizes, int n_in, void* d_out, int out_size, void* d_ws, size_t ws_size, hipStream_t stream) {
    static int grid = 0;
    if (grid == 0) {
        if (n_in != 14 || in_sizes[0] != M * DM || out_size != M * DM || ws_size < WS_END) { fprintf(stderr, "kernel_launch: unexpected shapes / workspace (n_in %d, ws %zu); nothing launched\n", n_in, ws_size); grid = -1; return; }
        int dev = 0, cus = 0, per_cu = 0;
        if (hipGetDevice(&dev) != hipSuccess || hipDeviceGetAttribute(&cus, hipDeviceAttributeMultiprocessorCount, dev) != hipSuccess) { grid = -1; return; }
        if (hipFuncSetAttribute((const void*)fwd_megakernel, hipFuncAttributeMaxDynamicSharedMemorySize, LDS_BYTES) != hipSuccess) { fprintf(stderr, "kernel_launch: hipFuncSetAttribute failed\n"); grid = -1; return; }
        if (hipOccupancyMaxActiveBlocksPerMultiprocessor(&per_cu, (const void*)fwd_megakernel, NTHR, LDS_BYTES) != hipSuccess || per_cu < 1) { fprintf(stderr, "kernel_launch: occupancy query says %d\n", per_cu); per_cu = 1; }
        (void)hipGetLastError();
        grid = cus * per_cu;
    }
    if (grid < 0) return;
    (void)hipMemsetAsync((char*)d_ws + WS_CTL, 0, 4096, stream);
    Args a{};
    for (int i = 0; i < 14; ++i) a.in[i] = (const float*)d_in[i];
    a.out = (float*)d_out; a.ws = (unsigned char*)d_ws;
#if MK_N_LAUNCHES == 1
    a.ph_lo = 0; a.ph_hi = NPHASE;
    void* kargs[] = {&a};
    hipError_t e = hipLaunchCooperativeKernel((const void*)fwd_megakernel, dim3(grid), dim3(NTHR), kargs, LDS_BYTES, stream);
    if (e != hipSuccess) fprintf(stderr, "cooperative launch failed: %s (grid %d)\n", hipGetErrorString(e), grid);
#else
    for (int p = 0; p < NPHASE; ++p) { a.ph_lo = p; a.ph_hi = p + 1; hipLaunchKernelGGL(fwd_megakernel, dim3(grid), dim3(NTHR), LDS_BYTES, stream, a); }
#endif
}
```

```cpp
#include <hip/hip_runtime.h>
#include <hip/hip_cooperative_groups.h>
#include <cstdio>
#include <cstdint>
namespace cg = cooperative_groups;
#ifndef MK_N_LAUNCHES
#define MK_N_LAUNCHES 1
#endif
constexpr float C2 = 0.125f * 1.4426950408889634f;
constexpr float DN_ALPHA = 1.1892071150027210f;
namespace pg8 {
#define PG8_LAS __attribute__((address_space(3)))
typedef unsigned short bf16_t;
typedef short bf16x8 __attribute__((ext_vector_type(8)));
typedef float f32x4 __attribute__((ext_vector_type(4)));
typedef unsigned u32x4 __attribute__((ext_vector_type(4)));
constexpr int BM = 256, BK = 64, HALF = 128, HTB = HALF * BK * 2  , STAGE_BYTES = 8 * HTB, NXCD = 8, WGM = 8;

__host__ __device__ __forceinline__ int lds_byte(int r, int c) { const int st = (r >> 4) * 2 + (c >> 5), rr = r & 15, cc = c & 31, ob = rr * 64 + cc * 2; return st * 1024 + (ob ^ (((ob >> 9) & 1) << 5)); }
__host__ __device__ __forceinline__ void stage_rc(int b, int& R, int& C) { const int st = b / 1024, sb = b % 1024, swz = sb ^ (((sb >> 9) & 1) << 5); R = (st >> 1) * 16 + swz / 64; C = (st & 1) * 32 + (swz % 64) / 2; }
__host__ __device__ __forceinline__ int perm32(int rho) { const int n = rho >> 4, i = rho & 15; return 8 * (i >> 2) + 4 * n + (i & 3); }

struct Unit { int pm, pn; };
struct Gemm { const bf16_t* A; const bf16_t* Bt; int M, N, K; };

struct StaticOrder {
    int nM, nN, nwg, G, c;
    __host__ __device__ void init(int M, int N, int G_, int c_) { nM = M / BM; nN = N / BM; nwg = nM * nN; G = G_; c = c_; }
    __host__ __device__ bool next(int i, Unit& u) const {
        const long L = (long)i * G + c; if (L >= nwg) return false;
        int wgid = (int)L; { const int q = nwg / NXCD, r = nwg % NXCD, xcd = wgid % NXCD, off = wgid / NXCD; wgid = (xcd < r ? xcd * (q + 1) : r * (q + 1) + (xcd - r) * q) + off; }
        const int nig = WGM * nN, gid = wgid / nig, fm = gid * WGM, gsz = (nM - fm) < WGM ? (nM - fm) : WGM;
        u.pm = fm + ((wgid % nig) % gsz); u.pn = (wgid % nig) / gsz; return true;
    }
    __device__ __forceinline__ void a_ready(const Unit&) const {}
    __device__ __forceinline__ void done(const Unit&) const {}
};

typedef float f32x2_cv __attribute__((ext_vector_type(2))); typedef __bf16 bf16x2_cv __attribute__((ext_vector_type(2)));
__device__ __forceinline__ unsigned cvt_pk_bf16(float lo, float hi) { f32x2_cv v = {lo, hi}; bf16x2_cv b = __builtin_convertvector(v, bf16x2_cv); return __builtin_bit_cast(unsigned, b); }
__device__ __forceinline__ u32x4 pack8(f32x4 a, f32x4 b) { u32x4 w; w.x = cvt_pk_bf16(a[0], a[1]); w.y = cvt_pk_bf16(a[2], a[3]); w.z = cvt_pk_bf16(b[0], b[1]); w.w = cvt_pk_bf16(b[2], b[3]); return w; }
__device__ __forceinline__ void unpack8(u32x4 w, f32x4& a, f32x4& b) {
    a[0] = __uint_as_float(w.x << 16); a[1] = __uint_as_float(w.x & 0xffff0000u); a[2] = __uint_as_float(w.y << 16); a[3] = __uint_as_float(w.y & 0xffff0000u);
    b[0] = __uint_as_float(w.z << 16); b[1] = __uint_as_float(w.z & 0xffff0000u); b[2] = __uint_as_float(w.w << 16); b[3] = __uint_as_float(w.w & 0xffff0000u); }
#define EPI_LOOP_AM _Pragma("unroll") for (int ai = 0; ai < 2; ++ai) _Pragma("unroll") for (int m = 0; m < 4; ++m)
#define EPI_ROW (u.pm * BM + ai * HALF + wr * 64 + m * 16 + fr)
#define EPI_COL(bj) (u.pn * BM + (bj) * HALF + wc * 32 + 8 * fq)

struct EpiBf16 { static constexpr bool PERM = true, AFTER_DRAIN = false; bf16_t* O0; bf16_t* O1; int ldc;
    __device__ __forceinline__ void operator()(const f32x4 (&acc)[2][2][4][2], const Unit& u, int wr, int wc, int fr, int fq) const {
        bf16_t* O = u.pm < 3 ? O0 : O1 - (size_t)768 * ldc;
        EPI_LOOP_AM { const size_t row = EPI_ROW;
#pragma unroll
            for (int bj = 0; bj < 2; ++bj) *(u32x4*)(O + row * ldc + EPI_COL(bj)) = pack8(acc[ai][bj][m][0], acc[ai][bj][m][1]); } }
};
struct EpiProj { static constexpr bool PERM = true, AFTER_DRAIN = false;
    bf16_t *QA, *KA, *QB, *KB, *QI, *KIWI; const float* cs;
    __device__ __forceinline__ void operator()(const f32x4 (&acc)[2][2][4][2], const Unit& u, int wr, int wc, int fr, int fq) const {
        const int pn = u.pn; bf16_t* dst; int ldc, colt; float sc = 1.f;
        if (pn < 3) { dst = QA; ldc = 768; colt = 256 * pn; sc = C2; } else if (pn < 6) { dst = KA; ldc = 768; colt = 256 * (pn - 3); }
        else if (pn < 9) { dst = QB; ldc = 768; colt = 256 * (pn - 6); sc = C2; } else if (pn < 12) { dst = KB; ldc = 768; colt = 256 * (pn - 9); }
        else if (pn < 14) { dst = QI; ldc = 512; colt = 256 * (pn - 12); } else { dst = KIWI; ldc = 128; colt = 0; }
        const bool last = pn == 14, ropeLane = ((wc & 1) == 0) && fq < 2; const float sgn = fq == 0 ? -1.f : 1.f;
        EPI_LOOP_AM { const size_t row = EPI_ROW;
            f32x4 c0 = {0, 0, 0, 0}, c1 = c0, s0 = c0, s1 = c0;
            if (ropeLane) { const f32x4* p = (const f32x4*)(cs + row * 16); c0 = p[0]; c1 = p[1]; s0 = p[2]; s1 = p[3]; }
#pragma unroll
            for (int bj = 0; bj < 2; ++bj) { f32x4 v0 = acc[ai][bj][m][0], v1 = acc[ai][bj][m][1], p0, p1;
#pragma unroll
                for (int k = 0; k < 4; ++k) { p0[k] = __shfl_xor(v0[k], 16); p1[k] = __shfl_xor(v1[k], 16); }
                const bool doRope = ropeLane && (!last || (bj == 0 && wc == 0));
                if (doRope) { v0 = v0 * c0 + (sgn * p0) * s0; v1 = v1 * c1 + (sgn * p1) * s1; }
                v0 = v0 * sc; v1 = v1 * sc;
                if (!last) *(u32x4*)(dst + row * ldc + colt + bj * HALF + wc * 32 + 8 * fq) = pack8(v0, v1);
                else if (bj == 0) { const int c = wc * 32 + 8 * fq;
                    if (c < 64) *(u32x4*)(KIWI + ((((row >> 5) * 4 + (c >> 4)) * 2 + ((c >> 3) & 1)) * 32 + (row & 31)) * 8) = pack8(v0, v1);
                    else if (c == 64) *(u32x4*)(KIWI + (size_t)2097152 + row * 8) = pack8(v0, v1); } } } }
};
struct EpiGate { static constexpr bool PERM = true, AFTER_DRAIN = false; bf16_t* O; int ldc; const float* bias;
    __device__ __forceinline__ void operator()(const f32x4 (&acc)[2][2][4][2], const Unit& u, int wr, int wc, int fr, int fq) const {
        f32x4 bv[2][2];
#pragma unroll
        for (int bj = 0; bj < 2; ++bj) { bv[bj][0] = *(const f32x4*)(bias + EPI_COL(bj)); bv[bj][1] = *(const f32x4*)(bias + EPI_COL(bj) + 4); }
        EPI_LOOP_AM { const size_t row = EPI_ROW;
#pragma unroll
            for (int bj = 0; bj < 2; ++bj) { f32x4 v[2];
#pragma unroll
                for (int n = 0; n < 2; ++n) { const f32x4 x = acc[ai][bj][m][n] + bv[bj][n];
#pragma unroll
                    for (int k = 0; k < 4; ++k) v[n][k] = __builtin_amdgcn_rcpf(1.f + __expf(-x[k])); }
                *(u32x4*)(O + row * ldc + EPI_COL(bj)) = pack8(v[0], v[1]); } } }
};
struct EpiBrA { static constexpr bool PERM = true, AFTER_DRAIN = false; float* T; const bf16_t* G;
    __device__ __forceinline__ void operator()(const f32x4 (&acc)[2][2][4][2], const Unit& u, int wr, int wc, int fr, int fq) const {
        EPI_LOOP_AM { const size_t row = EPI_ROW;
#pragma unroll
            for (int bj = 0; bj < 2; ++bj) { const int col = EPI_COL(bj); f32x4 g0, g1; unpack8(*(const u32x4*)(G + row * 2048 + col), g0, g1);
                *(f32x4*)(T + row * 1024 + col) = g0 * acc[ai][bj][m][0]; *(f32x4*)(T + row * 1024 + col + 4) = g1 * acc[ai][bj][m][1]; } } }
};
struct EpiBrB { static constexpr bool PERM = true, AFTER_DRAIN = false; const float* T; const bf16_t* G; bf16_t* O;
    __device__ __forceinline__ void operator()(const f32x4 (&acc)[2][2][4][2], const Unit& u, int wr, int wc, int fr, int fq) const {
        EPI_LOOP_AM { const size_t row = EPI_ROW;
#pragma unroll
            for (int bj = 0; bj < 2; ++bj) { const int col = EPI_COL(bj); f32x4 g0, g1; unpack8(*(const u32x4*)(G + row * 2048 + 1024 + col), g0, g1);
                const f32x4 t0 = *(const f32x4*)(T + row * 1024 + col), t1 = *(const f32x4*)(T + row * 1024 + col + 4);
                *(u32x4*)(O + row * 1024 + col) = pack8(t0 + g0 * acc[ai][bj][m][0], t1 + g1 * acc[ai][bj][m][1]); } } }
};
struct EpiRes { static constexpr bool PERM = true, AFTER_DRAIN = false; const float* R; float* Z;
    __device__ __forceinline__ void operator()(const f32x4 (&acc)[2][2][4][2], const Unit& u, int wr, int wc, int fr, int fq) const {
        EPI_LOOP_AM { const size_t row = EPI_ROW;
#pragma unroll
            for (int bj = 0; bj < 2; ++bj) { const int col = EPI_COL(bj);
                const f32x4 r0 = *(const f32x4*)(R + row * 1024 + col), r1 = *(const f32x4*)(R + row * 1024 + col + 4);
                *(f32x4*)(Z + row * 1024 + col) = r0 * DN_ALPHA + acc[ai][bj][m][0]; *(f32x4*)(Z + row * 1024 + col + 4) = r1 * DN_ALPHA + acc[ai][bj][m][1]; } } }
};
struct EpiSwiGLU { static constexpr bool PERM = true, AFTER_DRAIN = false; bf16_t* H;
    __device__ __forceinline__ void operator()(const f32x4 (&acc)[2][2][4][2], const Unit& u, int wr, int wc, int fr, int fq) const {
        EPI_LOOP_AM { const size_t row = EPI_ROW; f32x4 v[2];
#pragma unroll
            for (int n = 0; n < 2; ++n) { const f32x4 g = acc[ai][0][m][n], up = acc[ai][1][m][n];
#pragma unroll
                for (int k = 0; k < 4; ++k) v[n][k] = g[k] * __builtin_amdgcn_rcpf(1.f + __expf(-g[k])) * up[k]; }
            *(u32x4*)(H + row * 2816 + u.pn * HALF + wc * 32 + 8 * fq) = pack8(v[0], v[1]); } }
};
template <class Epi, class Sched, bool ALIGN_EPI = false, bool SP2 = false>
__device__ __forceinline__ void gemm_phase(PG8_LAS unsigned char* lds, const Gemm g, const Sched& S, const Epi& E) {
    const int tid = threadIdx.x, wid = __builtin_amdgcn_readfirstlane(tid >> 6), lane = tid & 63, wr = wid >> 2, wc = wid & 3, fr = lane & 15, fq = lane >> 4;
    const int K = g.K, nt = K / BK;
    unsigned voffA[2], voffB[2];
#pragma unroll
    for (int i = 0; i < 2; ++i) { int R, C; stage_rc(tid * 16 + i * 8192, R, C); const int Rb = Epi::PERM ? ((R & ~31) + perm32(R & 31)) : R;
        voffA[i] = (unsigned)(R * K + C) * 2u; voffB[i] = (unsigned)(Rb * K + C) * 2u; }
    const size_t kstep = (size_t)(BK * 2);
    const size_t hstep = (size_t)HALF * K * 2;
    const size_t tstep = 2 * hstep;
    const unsigned ldsw = (unsigned)wid * 1024u;
    const int aoff = lds_byte(wr * 64 + fr, fq * 8), boff = lds_byte(wc * 32 + fr, fq * 8);
#define PG8_SA(b, h) (((b) * 2 + (h)) * HTB)
#define PG8_SB(b, h) ((4 + (b) * 2 + (h)) * HTB)
#define PG8_STAGE(bufoff, gbase, voff) do { _Pragma("unroll") for (int _i = 0; _i < 2; ++_i) \
        __builtin_amdgcn_global_load_lds((const unsigned*)((const char*)(gbase) + (voff)[_i]), (PG8_LAS unsigned*)(lds + (bufoff) + ldsw + _i * 8192), 16, 0, 0); } while (0)
#define PG8_LDA(dst, b, h) do { _Pragma("unroll") for (int m = 0; m < 4; ++m) _Pragma("unroll") for (int k = 0; k < 2; ++k) dst[m][k] = *(const PG8_LAS bf16x8*)(lds + PG8_SA(b, h) + aoff + m * 2048 + k * 1024); } while (0)
#define PG8_LDB(dst, b, h) do { _Pragma("unroll") for (int n = 0; n < 2; ++n) _Pragma("unroll") for (int k = 0; k < 2; ++k) dst[n][k] = *(const PG8_LAS bf16x8*)(lds + PG8_SB(b, h) + boff + n * 2048 + k * 1024); } while (0)
#define PG8_MMA(ai, bj, At, Bt) do { __builtin_amdgcn_s_setprio(1); _Pragma("unroll") for (int m = 0; m < 4; ++m) _Pragma("unroll") for (int n = 0; n < 2; ++n) _Pragma("unroll") for (int k = 0; k < 2; ++k) \
        acc[ai][bj][m][n] = __builtin_amdgcn_mfma_f32_16x16x32_bf16(Bt[n][k], At[m][k], acc[ai][bj][m][n], 0, 0, 0); __builtin_amdgcn_s_setprio(0); } while (0)
#define PG8_WAIT_V(n) asm volatile("s_waitcnt vmcnt(" #n ")" ::: "memory")
#define PG8_WAIT_L(n) asm volatile("s_waitcnt lgkmcnt(" #n ")" ::: "memory")
#define PG8_BAR __builtin_amdgcn_s_barrier()
#define PG8_SCHED __builtin_amdgcn_sched_barrier(0)
    Unit cur, nxt; int ui = 0;
    if (!S.next(0, cur)) return;
    f32x4 acc[2][2][4][2];
#pragma unroll
    for (int a = 0; a < 2; ++a)
#pragma unroll
        for (int b = 0; b < 2; ++b)
#pragma unroll
            for (int m = 0; m < 4; ++m)
#pragma unroll
                for (int n = 0; n < 2; ++n) acc[a][b][m][n] = (f32x4){0.f, 0.f, 0.f, 0.f};
    bf16x8 At[4][2], B0[2][2], B1[2][2];
    const char* cA = (const char*)g.A + (size_t)cur.pm * tstep; const char* cB = (const char*)g.Bt + (size_t)cur.pn * tstep;
    S.a_ready(cur);
    if constexpr (SP2) {
        PG8_STAGE(PG8_SB(0, 0), cB, voffB); PG8_STAGE(PG8_SB(0, 1), cB + hstep, voffB); PG8_STAGE(PG8_SA(0, 0), cA, voffA); PG8_STAGE(PG8_SA(0, 1), cA + hstep, voffA);
        if (wr == 1) PG8_BAR;
        PG8_WAIT_V(2); PG8_BAR;
        PG8_STAGE(PG8_SB(1, 0), cB + kstep, voffB); PG8_STAGE(PG8_SA(1, 0), cA + kstep, voffA); PG8_STAGE(PG8_SB(1, 1), cB + hstep + kstep, voffB);
        PG8_WAIT_V(6); PG8_BAR;
    } else {
        PG8_STAGE(PG8_SB(0, 0), cB, voffB); PG8_STAGE(PG8_SA(0, 0), cA, voffA); PG8_STAGE(PG8_SB(0, 1), cB + hstep, voffB); PG8_STAGE(PG8_SA(0, 1), cA + hstep, voffA);
        if (wr == 1) PG8_BAR;
        PG8_WAIT_V(4); PG8_BAR;
        PG8_STAGE(PG8_SB(1, 0), cB + kstep, voffB); PG8_STAGE(PG8_SA(1, 0), cA + kstep, voffA); PG8_STAGE(PG8_SB(1, 1), cB + hstep + kstep, voffB);
        PG8_WAIT_V(6); PG8_BAR;
    }
    for (;;) {
        const bool has_next = S.next(ui + 1, nxt);
        const char* nA = has_next ? (const char*)g.A + (size_t)nxt.pm * tstep : cA; const char* nB = has_next ? (const char*)g.Bt + (size_t)nxt.pn * tstep : cB;
        for (int t = 0; t < nt; t += 2) {
            const bool last = (t == nt - 2);
            const char* a1 = cA + (size_t)(t + 1) * kstep;
            const char* a2 = last ? nA : cA + (size_t)(t + 2) * kstep; const char* b2 = last ? nB : cB + (size_t)(t + 2) * kstep;
            const char* a3 = a2 + kstep; const char* b3 = b2 + kstep;
            if (last && has_next) S.a_ready(nxt);
            if constexpr (SP2) {
            PG8_LDB(B0, 0, 0); PG8_LDB(B1, 0, 1); PG8_SCHED; PG8_LDA(At, 0, 0); PG8_STAGE(PG8_SA(1, 1), a1 + hstep, voffA);
            PG8_WAIT_V(8); PG8_WAIT_L(0); PG8_BAR; PG8_MMA(0, 0, At, B0); PG8_MMA(0, 1, At, B1); PG8_BAR; PG8_SCHED;
            PG8_LDA(At, 0, 1); PG8_STAGE(PG8_SB(0, 0), b2, voffB); PG8_STAGE(PG8_SB(0, 1), b2 + hstep, voffB); PG8_STAGE(PG8_SA(0, 0), a2, voffA);
            PG8_WAIT_V(8); PG8_WAIT_L(0); PG8_BAR; PG8_MMA(1, 0, At, B0); PG8_MMA(1, 1, At, B1); PG8_BAR; PG8_SCHED;
            PG8_LDB(B0, 1, 0); PG8_LDB(B1, 1, 1); PG8_SCHED; PG8_LDA(At, 1, 0); PG8_STAGE(PG8_SA(0, 1), a2 + hstep, voffA);
            PG8_WAIT_V(8); PG8_WAIT_L(0); PG8_BAR; PG8_MMA(0, 0, At, B0); PG8_MMA(0, 1, At, B1); PG8_BAR; PG8_SCHED;
            PG8_LDA(At, 1, 1); PG8_STAGE(PG8_SB(1, 0), b3, voffB); PG8_STAGE(PG8_SB(1, 1), b3 + hstep, voffB); PG8_STAGE(PG8_SA(1, 0), a3, voffA);
            PG8_WAIT_V(8); PG8_WAIT_L(0); PG8_BAR; PG8_MMA(1, 0, At, B0); PG8_MMA(1, 1, At, B1); PG8_BAR; PG8_SCHED;
            } else {
            PG8_LDB(B0, 0, 0); PG8_SCHED; PG8_LDA(At, 0, 0); PG8_STAGE(PG8_SA(1, 1), a1 + hstep, voffA);
            PG8_WAIT_L(8); PG8_BAR; PG8_WAIT_L(0); PG8_MMA(0, 0, At, B0); PG8_BAR; PG8_SCHED;
            PG8_LDB(B1, 0, 1); PG8_STAGE(PG8_SB(0, 0), b2, voffB);
            PG8_BAR; PG8_WAIT_L(0); PG8_MMA(0, 1, At, B1); PG8_BAR;
            PG8_LDA(At, 0, 1); PG8_STAGE(PG8_SA(0, 0), a2, voffA);
            PG8_BAR; PG8_WAIT_L(0); PG8_MMA(1, 0, At, B0); PG8_BAR; PG8_SCHED;
            PG8_STAGE(PG8_SB(0, 1), b2 + hstep, voffB);
            PG8_WAIT_V(6); PG8_BAR; PG8_MMA(1, 1, At, B1); PG8_BAR;
            PG8_LDB(B0, 1, 0); PG8_SCHED; PG8_LDA(At, 1, 0); PG8_STAGE(PG8_SA(0, 1), a2 + hstep, voffA);
            PG8_WAIT_L(8); PG8_BAR; PG8_WAIT_L(0); PG8_MMA(0, 0, At, B0); PG8_BAR; PG8_SCHED;
            PG8_LDB(B1, 1, 1); PG8_STAGE(PG8_SB(1, 0), b3, voffB);
            PG8_BAR; PG8_WAIT_L(0); PG8_MMA(0, 1, At, B1); PG8_BAR;
            PG8_LDA(At, 1, 1); PG8_STAGE(PG8_SA(1, 0), a3, voffA);
            PG8_BAR; PG8_WAIT_L(0); PG8_MMA(1, 0, At, B0); PG8_BAR; PG8_SCHED;
            PG8_STAGE(PG8_SB(1, 1), b3 + hstep, voffB);
            PG8_WAIT_V(6); PG8_BAR; PG8_MMA(1, 1, At, B1); PG8_BAR;
            }
        }
        if constexpr (ALIGN_EPI) { if (wr == 0) PG8_BAR; }
        if constexpr (!Epi::AFTER_DRAIN) { E(acc, cur, wr, wc, fr, fq); S.done(cur); }
        if (!has_next) break;
#pragma unroll
        for (int a = 0; a < 2; ++a)
#pragma unroll
            for (int b = 0; b < 2; ++b)
#pragma unroll
                for (int m = 0; m < 4; ++m)
#pragma unroll
                    for (int n = 0; n < 2; ++n) acc[a][b][m][n] = (f32x4){0.f, 0.f, 0.f, 0.f};
        cur = nxt; cA = nA; cB = nB; ++ui;
        if constexpr (ALIGN_EPI) { if (wr == 1) PG8_BAR; }
    }
    PG8_WAIT_V(0);
    if constexpr (!ALIGN_EPI) { if (wr == 0) PG8_BAR; }
    PG8_BAR;
    if constexpr (Epi::AFTER_DRAIN) { E.fused(acc, cur, wr, wc, fr, fq, lds, wid, lane); S.done(cur); }
#undef PG8_SA
#undef PG8_SB
#undef PG8_STAGE
#undef PG8_LDA
#undef PG8_LDB
#undef PG8_MMA
#undef PG8_WAIT_V
#undef PG8_WAIT_L
#undef PG8_BAR
#undef PG8_SCHED
}
}
#define LAS __attribute__((address_space(3)))
typedef unsigned short bf16;
typedef short bf16x8 __attribute__((ext_vector_type(8)));
typedef float f32x4 __attribute__((ext_vector_type(4)));
typedef float f32x16 __attribute__((ext_vector_type(16)));
typedef unsigned u32x4 __attribute__((ext_vector_type(4)));
typedef unsigned u32x2 __attribute__((ext_vector_type(2)));
typedef unsigned long long u64;
constexpr int NWAVES = 8, NTHR = 512;
constexpr int BATCH = 8, SEQ = 4096, DM = 1024, M = BATCH * SEQ, FFN = 2816;
constexpr int NPROJ = 3840, NVT = 1536, NGATE = 2048, NGU = 5632;
constexpr size_t MiB = 1u << 20;
constexpr size_t WS_CTL = 0;
constexpr size_t WS_WIN = 1 * MiB, WS_WV = WS_WIN + (size_t)NPROJ * DM * 2, WS_WGATE = WS_WV + (size_t)NVT * DM * 2, WS_WA = WS_WGATE + (size_t)NGATE * DM * 2,
                 WS_WB = WS_WA + (size_t)DM * 768 * 2, WS_WO = WS_WB + (size_t)DM * 256 * 2, WS_WGU = WS_WO + (size_t)DM * DM * 2, WS_WD = WS_WGU + (size_t)NGU * DM * 2,
                 WS_WEND = WS_WD + (size_t)DM * FFN * 2;
static_assert(WS_WEND <= 36 * MiB, "weights");
constexpr size_t WS_CS = 36 * MiB, WS_MASK = 38 * MiB, WS_XB = 54 * MiB, WS_QA = 118 * MiB, WS_KA = 166 * MiB, WS_VAT = 214 * MiB, WS_QB = 262 * MiB, WS_KB = 310 * MiB,
                 WS_VBT = 358 * MiB, WS_QI = 406 * MiB, WS_KIWI = 438 * MiB, WS_LSE = 446 * MiB, WS_OBC = 448 * MiB, WS_END = 464 * MiB;
constexpr size_t WS_GATE = 310 * MiB  , WS_MIXED = 166 * MiB  , WS_X1B = 54 * MiB  , WS_H = 118 * MiB  ;
static_assert(WS_H + (size_t)M * FFN * 2 <= WS_GATE + 128 * MiB, "map");
constexpr int LDS_BYTES = 147456;
constexpr int SCP = 4128;

__device__ __forceinline__ unsigned f2bf(float f) { unsigned u = __builtin_bit_cast(unsigned, f); return (u + 0x7fffu + ((u >> 16) & 1u)) >> 16; }
__device__ __forceinline__ unsigned pk2(float lo, float hi) { return f2bf(lo) | (f2bf(hi) << 16); }
__device__ __forceinline__ float bf_lo(unsigned w) { return __uint_as_float(w << 16); }
__device__ __forceinline__ float bf_hi(unsigned w) { return __uint_as_float(w & 0xffff0000u); }
__device__ __forceinline__ float wave_sum(float v) {
#pragma unroll
    for (int o = 1; o < 64; o <<= 1) v += __shfl_xor(v, o);
    return v; }

struct Args { const float* in[14]; float* out; unsigned char* ws; int ph_lo, ph_hi; };

__device__ __forceinline__ void tr_item(const float* W, int ld, int K, int c0, int nvalid, bf16* WT, int r0, int k0, LAS float* scr, int lane) {
    float tv[32];
#pragma unroll
    for (int i = 0; i < 32; ++i) { const int kk = 2 * i + (lane >> 5), n = lane & 31; tv[i] = (n < nvalid) ? W[(size_t)(k0 + kk) * ld + c0 + n] : 0.f; }
#pragma unroll
    for (int i = 0; i < 32; ++i) { const int kk = 2 * i + (lane >> 5), n = lane & 31; scr[kk * 33 + n] = tv[i]; }
    asm volatile("s_waitcnt lgkmcnt(0)" ::: "memory");
    const int c = lane & 7;
#pragma unroll
    for (int j = 0; j < 4; ++j) { const int n = (lane >> 3) + 8 * j; const LAS float* s = scr + (8 * c) * 33 + n;
        u32x4 o; o.x = pk2(s[0 * 33], s[1 * 33]); o.y = pk2(s[2 * 33], s[3 * 33]); o.z = pk2(s[4 * 33], s[5 * 33]); o.w = pk2(s[6 * 33], s[7 * 33]);
        *(u32x4*)(WT + (size_t)(r0 + n) * K + k0 + 8 * c) = o; }
    asm volatile("s_waitcnt lgkmcnt(0)" ::: "memory");
}
__device__ __forceinline__ void p0_prologue(const Args& a, LAS unsigned char* lds, int gw, int NGW, int wave, int lane) {
    unsigned char* ws = a.ws;
    LAS float* scr = (LAS float*)(lds + wave * 16384);
    const float* w_in = a.in[2];
    int it = gw;
    for (;; it += NGW) {
        int r = it; const float* src; int ld, K, col0, ncols, row0, mode = 0; bf16* dst;
#define SEC(S, LD, KK, C0, NC, DST, R0, MODE) { const int n_ = ((KK) / 64) * (((NC) + 31) / 32); if (r < n_) { src = (S); ld = (LD); K = (KK); col0 = (C0); ncols = (NC); dst = (bf16*)(ws + (DST)); row0 = (R0); mode = (MODE); goto found; } r -= n_; }
        SEC(w_in, 7240, 1024, 0, 768, WS_WIN, 0, 0)
        SEC(w_in, 7240, 1024, 768, 768, WS_WIN, 768, 0)
        SEC(w_in, 7240, 1024, 1536, 768, WS_WV, 0, 0)
        SEC(w_in, 7240, 1024, 2304, 768, WS_WIN, 1536, 0)
        SEC(w_in, 7240, 1024, 3072, 768, WS_WIN, 2304, 0)
        SEC(w_in, 7240, 1024, 3840, 768, WS_WV, 768, 0)
        SEC(w_in, 7240, 1024, 4608, 512, WS_WIN, 3072, 0)
        SEC(w_in, 7240, 1024, 5120, 64, WS_WIN, 3584, 0)
        SEC(w_in, 7240, 1024, 5184, 8, WS_WIN, 3648, 0)
        SEC(w_in, 7240, 1024, 5192, 2048, WS_WGATE, 0, 0)
        SEC(a.in[4], 1024, 768, 0, 1024, WS_WA, 0, 0)
        SEC(a.in[5], 1024, 256, 0, 1024, WS_WB, 0, 0)
        SEC(a.in[6], 1024, 1024, 0, 1024, WS_WO, 0, 0)
        SEC(a.in[9], 2816, 1024, 0, 2816, WS_WGU, 0, 1)
        SEC(a.in[10], 2816, 1024, 0, 2816, WS_WGU, 128, 1)
        SEC(a.in[11], 1024, 2816, 0, 1024, WS_WD, 0, 0)
#undef SEC
        break;
    found:;
        const int nblk = (ncols + 31) / 32, kb = r / nblk, nb = r % nblk, n0 = 32 * nb;
        const int nvalid = (ncols - n0) < 32 ? (ncols - n0) : 32;
        const int r0 = row0 + (mode ? 256 * (n0 / 128) + (n0 % 128) : n0);
        tr_item(src, ld, K, col0 + n0, nvalid, dst, r0, 64 * kb, scr, lane);
    }
    { u32x4* p = (u32x4*)(ws + WS_WIN + (size_t)3680 * DM * 2); const int n16 = 160 * DM * 2 / 16;
      for (int i = gw * 64 + lane; i < n16; i += NGW * 64) p[i] = (u32x4){0u, 0u, 0u, 0u}; }
    { const f32x4* x4 = (const f32x4*)a.in[0]; u32x4* xb = (u32x4*)(ws + WS_XB); const int n8 = M * DM / 8; const int stride = NGW * 64;
      for (int i = gw * 64 + lane; i < n8; i += 4 * stride) { f32x4 p[4], q[4];
#pragma unroll
          for (int u = 0; u < 4; ++u) { const int ii = i + u * stride; if (ii < n8) { p[u] = x4[2 * ii]; q[u] = x4[2 * ii + 1]; } }
#pragma unroll
          for (int u = 0; u < 4; ++u) { const int ii = i + u * stride; if (ii < n8) { u32x4 o; o.x = pk2(p[u][0], p[u][1]); o.y = pk2(p[u][2], p[u][3]); o.z = pk2(q[u][0], q[u][1]); o.w = pk2(q[u][2], q[u][3]); xb[ii] = o; } } } }
    { const int* pos = (const int*)a.in[1]; float* cs = (float*)(ws + WS_CS);
      for (int i = gw * 64 + lane; i < M * 8; i += NGW * 64) { const int row = i >> 3, f = i & 7;
          const float inv = powf(500000.0f, -(float)(2 * f) / 16.0f); const float ang = (float)pos[row] * inv;
          cs[row * 16 + f] = cosf(ang); cs[row * 16 + 8 + f] = sinf(ang); } }
}

#define WRL(dst, sval, ln) asm volatile("s_nop 4\n\tv_writelane_b32 %0, %1, %2\n\ts_nop 1" : "+v"(dst) : "s"(sval), "i"(ln))
__device__ __forceinline__ void indexer_phase(LAS unsigned char* lds, const bf16* QI, const bf16* KIWI, u64* MASK, int blk, int nblk, int wid, int lane) {
    LAS float* sc = (LAS float*)lds;
    const int m = lane & 31, kh = lane >> 5;
    const int qloc = 2 * ((m >> 2) & 1) + ((m >> 4) & 1), head = 4 * ((m >> 3) & 1) + (m & 3);
    bf16x8 qf[2][4]; u32x4 wraw[2][2]; bf16x8 k0[4], k1[4], k2[4], k3[4];
#define LOADK(buf, KT) do { const int ktc_ = (KT) < nkt ? (KT) : nkt - 1; const bf16* kp_ = kbase + (size_t)ktc_ * 2048; _Pragma("unroll") for (int kk = 0; kk < 4; ++kk) buf[kk] = *(const bf16x8*)(kp_ + 512 * kk); } while (0)
#define LOAD_UNIT(U) do { const int b_ = (U) & 7, t0_ = ((U) >> 3) * 8; const size_t rb_ = (size_t)b_ * SEQ; \
        _Pragma("unroll") for (int r2 = 0; r2 < 2; ++r2) { const bf16* qp = QI + (rb_ + t0_ + 4 * r2 + qloc) * 512 + head * 64 + 8 * kh; \
            _Pragma("unroll") for (int kk = 0; kk < 4; ++kk) qf[r2][kk] = *(const bf16x8*)(qp + 16 * kk); \
            _Pragma("unroll") for (int i = 0; i < 2; ++i) wraw[r2][i] = *(const u32x4*)(KIWI + (size_t)2097152 + (rb_ + t0_ + 4 * r2 + 2 * kh + i) * 8); } \
        { const int nkt = (t0_ + 7) / 32 + 1; const bf16* kbase = KIWI + (rb_ / 32) * 2048 + (kh * 32 + m) * 8; LOADK(k0, wid); LOADK(k1, wid + 8); LOADK(k2, wid + 16); } } while (0)
    if (blk < BATCH * (SEQ / 8)) LOAD_UNIT(blk);
    for (int u = blk; u < BATCH * (SEQ / 8); u += nblk) {
        const int b = u & 7, t0 = (u >> 3) * 8;
        const size_t rb = (size_t)b * SEQ;
        {
            float wv[2][2][8];
#pragma unroll
            for (int r2 = 0; r2 < 2; ++r2)
#pragma unroll
                for (int i = 0; i < 2; ++i) { const u32x4 w = wraw[r2][i];
                    wv[r2][i][0] = bf_lo(w.x); wv[r2][i][1] = bf_hi(w.x); wv[r2][i][2] = bf_lo(w.y); wv[r2][i][3] = bf_hi(w.y); wv[r2][i][4] = bf_lo(w.z); wv[r2][i][5] = bf_hi(w.z); wv[r2][i][6] = bf_lo(w.w); wv[r2][i][7] = bf_hi(w.w); }
            const int nkt = (t0 + 7) / 32 + 1;
            const bf16* kbase = KIWI + (rb / 32) * 2048 + (kh * 32 + m) * 8;
#define COMPK(buf, KT) do { if ((KT) < nkt) { const int key = 32 * (KT) + m; \
                f32x16 a0 = {0, 0, 0, 0, 0, 0, 0, 0, 0, 0, 0, 0, 0, 0, 0, 0}, a1 = a0; \
                _Pragma("unroll") for (int kk = 0; kk < 4; ++kk) { a0 = __builtin_amdgcn_mfma_f32_32x32x16_bf16(qf[0][kk], buf[kk], a0, 0, 0, 0); a1 = __builtin_amdgcn_mfma_f32_32x32x16_bf16(qf[1][kk], buf[kk], a1, 0, 0, 0); } \
                _Pragma("unroll") for (int i = 0; i < 2; ++i) { float r0_[8], r1_[8]; \
                    _Pragma("unroll") for (int h = 0; h < 8; ++h) { r0_[h] = __builtin_amdgcn_fmed3f(a0[8 * i + h], 0.f, __builtin_inff()); r1_[h] = __builtin_amdgcn_fmed3f(a1[8 * i + h], 0.f, __builtin_inff()); } \
                    const float pa_ = fmaf(wv[0][i][1], r0_[1], wv[0][i][0] * r0_[0]), pb_ = fmaf(wv[0][i][3], r0_[3], wv[0][i][2] * r0_[2]), pc_ = fmaf(wv[0][i][5], r0_[5], wv[0][i][4] * r0_[4]), pd_ = fmaf(wv[0][i][7], r0_[7], wv[0][i][6] * r0_[6]); \
                    const float qa_ = fmaf(wv[1][i][1], r1_[1], wv[1][i][0] * r1_[0]), qb_ = fmaf(wv[1][i][3], r1_[3], wv[1][i][2] * r1_[2]), qc_ = fmaf(wv[1][i][5], r1_[5], wv[1][i][4] * r1_[4]), qd_ = fmaf(wv[1][i][7], r1_[7], wv[1][i][6] * r1_[6]); \
                    const float s0_ = (pa_ + pb_) + (pc_ + pd_), s1_ = (qa_ + qb_) + (qc_ + qd_); \
                    sc[(2 * kh + i) * SCP + key] = s0_ + 0.0f; sc[(4 + 2 * kh + i) * SCP + key] = s1_ + 0.0f; } } } while (0)
            int kt = wid;
            for (; kt < nkt; kt += 32) {
                LOADK(k3, kt + 24); COMPK(k0, kt);
                LOADK(k0, kt + 32); COMPK(k1, kt + 8);
                LOADK(k1, kt + 40); COMPK(k2, kt + 16);
                LOADK(k2, kt + 48); COMPK(k3, kt + 24);
            }
#undef COMPK
            if (u + nblk < BATCH * (SEQ / 8)) LOAD_UNIT(u + nblk);
        }
        __syncthreads();
        {
            const int t = t0 + wid, jmax = t >> 6;
            unsigned uv[64]; const int lim = t - lane;
#pragma unroll
            for (int j = 0; j < 64; ++j) { const unsigned bts = __float_as_uint(sc[wid * SCP + 64 * j + lane]);
                const unsigned s = bts ^ ((unsigned)((int)bts >> 31) | 0x80000000u); uv[j] = (64 * j <= lim) ? s : 0u; }
            unsigned mw_lo = 0u, mw_hi = 0u;
            u64 mm[8];
#define CMP8(OP, OFF, C) asm("v_cmp_" OP "_u32_e64 %0, %8, %16\n\tv_cmp_" OP "_u32_e64 %1, %9, %16\n\tv_cmp_" OP "_u32_e64 %2, %10, %16\n\tv_cmp_" OP "_u32_e64 %3, %11, %16\n\t" \
                "v_cmp_" OP "_u32_e64 %4, %12, %16\n\tv_cmp_" OP "_u32_e64 %5, %13, %16\n\tv_cmp_" OP "_u32_e64 %6, %14, %16\n\tv_cmp_" OP "_u32_e64 %7, %15, %16" \
                : "=&s"(mm[0]), "=&s"(mm[1]), "=&s"(mm[2]), "=&s"(mm[3]), "=&s"(mm[4]), "=&s"(mm[5]), "=&s"(mm[6]), "=&s"(mm[7]) \
                : "v"(uv[(OFF) + 0]), "v"(uv[(OFF) + 1]), "v"(uv[(OFF) + 2]), "v"(uv[(OFF) + 3]), "v"(uv[(OFF) + 4]), "v"(uv[(OFF) + 5]), "v"(uv[(OFF) + 6]), "v"(uv[(OFF) + 7]), "s"(C))
#define POP8() (__popcll(mm[0]) + __popcll(mm[1]) + __popcll(mm[2]) + __popcll(mm[3]) + __popcll(mm[4]) + __popcll(mm[5]) + __popcll(mm[6]) + __popcll(mm[7]))
#define WRL8(OFF) asm volatile("s_nop 4\n\tv_writelane_b32 %0, %2, %18\n\tv_writelane_b32 %1, %3, %18\n\tv_writelane_b32 %0, %4, %19\n\tv_writelane_b32 %1, %5, %19\n\t" \
                "v_writelane_b32 %0, %6, %20\n\tv_writelane_b32 %1, %7, %20\n\tv_writelane_b32 %0, %8, %21\n\tv_writelane_b32 %1, %9, %21\n\t" \
                "v_writelane_b32 %0, %10, %22\n\tv_writelane_b32 %1, %11, %22\n\tv_writelane_b32 %0, %12, %23\n\tv_writelane_b32 %1, %13, %23\n\t" \
                "v_writelane_b32 %0, %14, %24\n\tv_writelane_b32 %1, %15, %24\n\tv_writelane_b32 %0, %16, %25\n\tv_writelane_b32 %1, %17, %25\n\ts_nop 1" \
                : "+v"(mw_lo), "+v"(mw_hi) \
                : "s"((unsigned)mm[0]), "s"((unsigned)(mm[0] >> 32)), "s"((unsigned)mm[1]), "s"((unsigned)(mm[1] >> 32)), "s"((unsigned)mm[2]), "s"((unsigned)(mm[2] >> 32)), "s"((unsigned)mm[3]), "s"((unsigned)(mm[3] >> 32)), \
                  "s"((unsigned)mm[4]), "s"((unsigned)(mm[4] >> 32)), "s"((unsigned)mm[5]), "s"((unsigned)(mm[5] >> 32)), "s"((unsigned)mm[6]), "s"((unsigned)(mm[6] >> 32)), "s"((unsigned)mm[7]), "s"((unsigned)(mm[7] >> 32)), \
                  "i"((OFF) + 0), "i"((OFF) + 1), "i"((OFF) + 2), "i"((OFF) + 3), "i"((OFF) + 4), "i"((OFF) + 5), "i"((OFF) + 6), "i"((OFF) + 7))
            if (t < 256) {
#pragma unroll
                for (int j = 0; j < 4; ++j) { const u64 wd = __ballot(64 * j + lane <= t); WRL(mw_lo, (unsigned)wd, j); WRL(mw_hi, (unsigned)(wd >> 32), j); }
            } else {
                unsigned um = 0u;
#pragma unroll
                for (int j = 0; j < 64; ++j) um = uv[j] > um ? uv[j] : um;
#pragma unroll
                for (int o = 1; o < 64; o <<= 1) { const unsigned x = (unsigned)__shfl_xor((int)um, o); um = x > um ? x : um; }
                unsigned lo = 1u, hi = (unsigned)__builtin_amdgcn_readfirstlane(um) + 1u, ustar = 1u; int c_lo = t + 1, c_hi = 0, cge = 0; bool bis = false;
                for (;;) {
                    const unsigned width = hi - lo;
                    if (width <= 1u) { ustar = lo; cge = c_lo; break; }
                    unsigned step;
                    if (bis) step = width >> 1;
                    else { const float frac = ((float)(c_lo - 256) + 0.5f) / (float)(c_lo - c_hi); step = (unsigned)((float)width * frac); step = step < 1u ? 1u : step; step = step > width - 1u ? width - 1u : step; }
                    const unsigned cand = (unsigned)__builtin_amdgcn_readfirstlane(lo + step); int cnt = 0;
#pragma unroll
                    for (int g = 0; g < 8; ++g) if (8 * g <= jmax) { CMP8("ge", 8 * g, cand); cnt += POP8(); }
                    if (cnt == 256) { ustar = cand; cge = 256; break; }
                    if (cnt > 256) { lo = cand; c_lo = cnt; } else { hi = cand; c_hi = cnt; }
                    bis = (hi - lo) > (width >> 1);
                }
                ustar = __builtin_amdgcn_readfirstlane(ustar);
                if (cge == 256) {
#pragma unroll
                    for (int g = 0; g < 8; ++g) { CMP8("ge", 8 * g, ustar); WRL8(8 * g); }
                } else {
                    int cgt = 0;
#pragma unroll
                    for (int j = 0; j < 64; ++j) { cgt += __popcll(__ballot(uv[j] > ustar)); __builtin_amdgcn_sched_barrier(0); }
                    int remaining = 256 - cgt; asm volatile("" : "+s"(ustar));
#pragma unroll
                    for (int j = 0; j < 64; ++j) { const bool eq = uv[j] == ustar; const u64 em = __ballot(eq);
                        const int rank = __builtin_amdgcn_mbcnt_hi((unsigned)(em >> 32), __builtin_amdgcn_mbcnt_lo((unsigned)em, 0u));
                        const bool sel = (uv[j] > ustar) || (eq && rank < remaining); const int c = __popcll(em); remaining -= (c < remaining ? c : remaining);
                        const u64 wd = __ballot(sel); WRL(mw_lo, (unsigned)wd, j); WRL(mw_hi, (unsigned)(wd >> 32), j); __builtin_amdgcn_sched_barrier(0); }
                }
            }
#undef CMP8
#undef POP8
#undef WRL8
            MASK[((size_t)(b * 64 + lane)) * SEQ + t] = ((u64)mw_hi << 32) | (u64)mw_lo;
        }
        __syncthreads();
    }
}

__device__ __forceinline__ int pi32(int r) { return (r & 0x13) | ((r & 4) << 1) | ((r & 8) >> 1); }
__device__ __forceinline__ void attn_unit(LAS unsigned char* lds, const bf16* Q, const bf16* K, const bf16* VT, bf16* O, float* LSE, const u64* MASK,
                                          bool isB, int b, int h, int q0, int t_lo, int t_hi, int win, int dsh, int tid, int wid, int lane, bool dry = false) {
    const int ql = lane & 31, hi = lane >> 5;
    const size_t rb = (size_t)b * SEQ; const int tq = q0 + 32 * wid + ql; const size_t rowq = rb + tq;
    bf16x8 qf[4];
#pragma unroll
    for (int kk = 0; kk < 4; ++kk) qf[kk] = *(const bf16x8*)(Q + rowq * 768 + h * 64 + 16 * kk + 8 * hi);
    f32x16 o0 = {0, 0, 0, 0, 0, 0, 0, 0, 0, 0, 0, 0, 0, 0, 0, 0}, o1 = o0;
    float m_run = -1e30f, l_run = 0.f, f_pend = 1.f; bool pend = false;
    const int sr = tid >> 3, scc = tid & 7;
    const bf16* ksrc = K + (rb + sr) * 768 + h * 64 + 8 * scc;
    const bf16* vsrc = VT + (size_t)(h * 64 + sr) * M + rb + 8 * scc;
    const int swoff = (sr * 72 + 8 * scc) * 2;
    const int kroff = (pi32(ql) * 72 + 8 * hi) * 2, vroff = 9216 + (ql * 72 + 8 * hi) * 2;
    const u64* mrow = MASK + (isB ? (size_t)0 : (size_t)b * 64 * SEQ + tq); const size_t mstr = isB ? 0 : SEQ;
    const u64 pat = (dsh == 0 ? ~0ull : (dsh == 2 ? 0x1111111111111111ull : 0x0001000100010001ull)) << (tq & ((1 << dsh) - 1));
    const int t_last = t_hi - 1;
    u32x4 kreg = *(const u32x4*)(ksrc + (size_t)64 * t_lo * 768), vreg = *(const u32x4*)(vsrc + 64 * t_lo);
    const int t1 = (t_lo + 1 < t_hi) ? t_lo + 1 : t_last;
    u32x4 kreg2 = *(const u32x4*)(ksrc + (size_t)64 * t1 * 768), vreg2 = *(const u32x4*)(vsrc + 64 * t1);
    u64 mw_cur = mrow[(size_t)t_lo * mstr];
    __syncthreads();
    *(LAS u32x4*)(lds + swoff) = kreg; *(LAS u32x4*)(lds + 9216 + swoff) = vreg;
    *(LAS u32x4*)(lds + 18432 + swoff) = kreg2; *(LAS u32x4*)(lds + 18432 + 9216 + swoff) = vreg2;
    __syncthreads();
#define QKT(SB, S0, S1) do { S0 = (f32x16){0, 0, 0, 0, 0, 0, 0, 0, 0, 0, 0, 0, 0, 0, 0, 0}; S1 = S0; \
        _Pragma("unroll") for (int kk = 0; kk < 4; ++kk) { const bf16x8 a0_ = *(const LAS bf16x8*)(lds + (SB) + kroff + 32 * kk), a1_ = *(const LAS bf16x8*)(lds + (SB) + kroff + 32 * 144 + 32 * kk); \
            S0 = __builtin_amdgcn_mfma_f32_32x32x16_bf16(a0_, qf[kk], S0, 0, 0, 0); S1 = __builtin_amdgcn_mfma_f32_32x32x16_bf16(a1_, qf[kk], S1, 0, 0, 0); } } while (0)
#define PVM(SB) do { _Pragma("unroll") for (int s_ = 0; s_ < 2; ++s_) _Pragma("unroll") for (int k2 = 0; k2 < 2; ++k2) { const int co = (32 * s_ + 16 * k2) * 2; \
            const bf16x8 v0_ = *(const LAS bf16x8*)(lds + (SB) + vroff + co), v1_ = *(const LAS bf16x8*)(lds + (SB) + vroff + 32 * 144 + co); \
            o0 = __builtin_amdgcn_mfma_f32_32x32x16_bf16(v0_, pf[s_][k2], o0, 0, 0, 0); o1 = __builtin_amdgcn_mfma_f32_32x32x16_bf16(v1_, pf[s_][k2], o1, 0, 0, 0); } } while (0)
#define RESC() do { if (__any(pend)) { _Pragma("unroll") for (int j = 0; j < 16; ++j) { o0[j] *= f_pend; o1[j] *= f_pend; } } } while (0)
    f32x16 sA0, sA1, sB0, sB1;
    QKT(0, sA0, sA1);
    bf16x8 pf[2][2];
#pragma unroll
    for (int s_ = 0; s_ < 2; ++s_)
#pragma unroll
        for (int k2 = 0; k2 < 2; ++k2) pf[s_][k2] = (bf16x8){0, 0, 0, 0, 0, 0, 0, 0};
    int stm = 0, st0 = 0, st1 = 18432, st2 = 36864, st3 = 55296;
#define STEP(C0, C1, N0, N1, T, LK, LV, WK, WV) do { const int t_ = (T); \
        RESC(); \
        { const int tl_ = (t_ + 3 < t_hi) ? t_ + 3 : t_last; LK = *(const u32x4*)(ksrc + (size_t)64 * tl_ * 768); LV = *(const u32x4*)(vsrc + 64 * tl_); } \
        const u64 mw_nx = mrow[(size_t)((t_ + 1 < t_hi) ? t_ + 1 : t_last) * mstr]; \
        u64 mw; { const int hi_i = tq - 64 * t_, lo_i = hi_i - win; \
            const u64 up = hi_i >= 63 ? ~0ull : (hi_i < 0 ? 0ull : ((2ull << hi_i) - 1ull)); const u64 lw = lo_i <= 0 ? ~0ull : (lo_i > 63 ? 0ull : (~0ull << lo_i)); \
            mw = isB ? (pat & up & lw) : mw_cur; } \
        QKT(st1, N0, N1); \
        PVM(stm); \
        const unsigned m0 = (unsigned)(mw >> (8 * hi)), m1 = (unsigned)(mw >> (32 + 8 * hi)); \
        const unsigned NEGB = 0xF149F2CAu; float mt_[16]; \
        _Pragma("unroll") for (int j = 0; j < 16; ++j) { const int bp = (j & 7) + 16 * (j >> 3); \
            const unsigned k0_ = (unsigned)__builtin_amdgcn_sbfe((int)m0, bp, 1), k1_ = (unsigned)__builtin_amdgcn_sbfe((int)m1, bp, 1); \
            C0[j] = __uint_as_float((__float_as_uint(C0[j]) & k0_) | (NEGB & ~k0_)); C1[j] = __uint_as_float((__float_as_uint(C1[j]) & k1_) | (NEGB & ~k1_)); \
            mt_[j] = __builtin_amdgcn_fmed3f(C0[j], C1[j], __builtin_inff()); } \
        _Pragma("unroll") for (int w_ = 8; w_ >= 1; w_ >>= 1) _Pragma("unroll") for (int j = 0; j < w_; ++j) mt_[j] = __builtin_amdgcn_fmed3f(mt_[j], mt_[j + w_], __builtin_inff()); \
        float mx = mt_[0]; \
        { auto rr_ = __builtin_amdgcn_permlane32_swap(__float_as_uint(mx), __float_as_uint(mx), false, false); mx = __builtin_amdgcn_fmed3f(__uint_as_float(rr_[0]), __uint_as_float(rr_[1]), __builtin_inff()); } \
        { const float mn = fmaxf(m_run, mx); pend = mn > m_run; f_pend = __builtin_amdgcn_exp2f(m_run - mn); m_run = mn; l_run *= f_pend; } \
        float pt_[16]; \
        _Pragma("unroll") for (int j = 0; j < 16; ++j) { C0[j] = __builtin_amdgcn_exp2f(C0[j] - m_run); C1[j] = __builtin_amdgcn_exp2f(C1[j] - m_run); pt_[j] = C0[j] + C1[j]; } \
        _Pragma("unroll") for (int w_ = 8; w_ >= 1; w_ >>= 1) _Pragma("unroll") for (int j = 0; j < w_; ++j) pt_[j] += pt_[j + w_]; \
        const float ps = pt_[0]; \
        l_run += ps; \
        _Pragma("unroll") for (int k2 = 0; k2 < 2; ++k2) { u32x4 w0, w1; \
            w0.x = pg8::cvt_pk_bf16(C0[8 * k2 + 0], C0[8 * k2 + 1]); w0.y = pg8::cvt_pk_bf16(C0[8 * k2 + 2], C0[8 * k2 + 3]); w0.z = pg8::cvt_pk_bf16(C0[8 * k2 + 4], C0[8 * k2 + 5]); w0.w = pg8::cvt_pk_bf16(C0[8 * k2 + 6], C0[8 * k2 + 7]); \
            w1.x = pg8::cvt_pk_bf16(C1[8 * k2 + 0], C1[8 * k2 + 1]); w1.y = pg8::cvt_pk_bf16(C1[8 * k2 + 2], C1[8 * k2 + 3]); w1.z = pg8::cvt_pk_bf16(C1[8 * k2 + 4], C1[8 * k2 + 5]); w1.w = pg8::cvt_pk_bf16(C1[8 * k2 + 6], C1[8 * k2 + 7]); \
            pf[0][k2] = __builtin_bit_cast(bf16x8, w0); pf[1][k2] = __builtin_bit_cast(bf16x8, w1); } \
        _Pragma("unroll") for (int g_ = 0; g_ < 16; ++g_) { __builtin_amdgcn_sched_group_barrier(0x008, 1, 0); __builtin_amdgcn_sched_group_barrier(0x002, 12, 0); } \
        *(LAS u32x4*)(lds + st2 + swoff) = WK; *(LAS u32x4*)(lds + st2 + 9216 + swoff) = WV; \
        __syncthreads(); \
        mw_cur = mw_nx; { const int r_ = (stm == st0) ? st3 : stm; stm = st0; st0 = st1; st1 = st2; st2 = r_; } } while (0)
    int t = t_lo;
    { const int tl_ = (t_lo + 2 < t_hi) ? t_lo + 2 : t_last; kreg2 = *(const u32x4*)(ksrc + (size_t)64 * tl_ * 768); vreg2 = *(const u32x4*)(vsrc + 64 * tl_); }
    for (; t + 1 < t_hi; t += 2) { STEP(sA0, sA1, sB0, sB1, t, kreg, vreg, kreg2, vreg2); STEP(sB0, sB1, sA0, sA1, t + 1, kreg2, vreg2, kreg, vreg); }
    if (t < t_hi) STEP(sA0, sA1, sB0, sB1, t, kreg, vreg, kreg2, vreg2);
    RESC();
    PVM(stm);
#undef STEP
#undef QKT
#undef PVM
#undef RESC
    const float lt = l_run + __shfl_xor(l_run, 32); const float inv = 1.0f / lt;
    if (dry && lt > -1.f) return;
    bf16* op = O + rowq * 768 + h * 64 + 4 * hi;
#pragma unroll
    for (int jg = 0; jg < 4; ++jg) { u32x2 w;
        w.x = pk2(o0[4 * jg] * inv, o0[4 * jg + 1] * inv); w.y = pk2(o0[4 * jg + 2] * inv, o0[4 * jg + 3] * inv); *(u32x2*)(op + 8 * jg) = w;
        w.x = pk2(o1[4 * jg] * inv, o1[4 * jg + 1] * inv); w.y = pk2(o1[4 * jg + 2] * inv, o1[4 * jg + 3] * inv); *(u32x2*)(op + 32 + 8 * jg) = w; }
    if (isB && hi == 0) LSE[rowq * 12 + h] = 0.6931471805599453f * (m_run + log2f(lt));
}
__device__ __forceinline__ void attn_phase(LAS unsigned char* lds, unsigned char* ws, unsigned* ctr, int tid, int wid, int lane, bool dry = false) {
    LAS int* slot = (LAS int*)(lds + 77824);
    for (;;) {
        __syncthreads();
        if (tid == 0) *slot = (int)atomicAdd(ctr, 1u);
        __syncthreads();
        const int k = *slot;
        if (k >= 3072) break;
        if (k < 1536) { const int qb = 15 - k / 96, rem = k % 96, b = rem / 12, h = rem % 12;
            attn_unit(lds, (const bf16*)(ws + WS_QA), (const bf16*)(ws + WS_KA), (const bf16*)(ws + WS_VAT), (bf16*)(ws + WS_QA), nullptr, (const u64*)(ws + WS_MASK),
                      false, b, h, 256 * qb, 0, 4 * qb + 4, 0, 0, tid, wid, lane, dry);
        } else { const int k2 = k - 1536, gs = 2 - k2 / 512, r = k2 % 512, qb = 15 - r / 32, rem = r % 32, b = rem / 4, hg = rem % 4;
            const int win = gs == 0 ? 128 : (gs == 1 ? 512 : 2048), dsh = gs == 0 ? 0 : (gs == 1 ? 2 : 4);
            const int q0 = 256 * qb; const int lo = q0 - win; const int t_lo = lo > 0 ? lo / 64 : 0;
            attn_unit(lds, (const bf16*)(ws + WS_QB), (const bf16*)(ws + WS_KB), (const bf16*)(ws + WS_VBT), (bf16*)(ws + WS_QB), (float*)(ws + WS_LSE), nullptr,
                      true, b, gs * 4 + hg, q0, t_lo, 4 * qb + 4, win, dsh, tid, wid, lane, dry);
        }
    }
}

__device__ __forceinline__ void combine_b(unsigned char* ws, int gw, int NGW, int lane) {
    const bf16* OB = (const bf16*)(ws + WS_QB); const float* LSE = (const float*)(ws + WS_LSE); bf16* OBC = (bf16*)(ws + WS_OBC);
    for (int row = gw; row < M; row += NGW) { const int hg = lane >> 4, c = (lane & 15) * 4;
        const float l0 = LSE[(size_t)row * 12 + hg], l1 = LSE[(size_t)row * 12 + 4 + hg], l2 = LSE[(size_t)row * 12 + 8 + hg];
        const float mx = fmaxf(l0, fmaxf(l1, l2)); const float e0 = __expf(l0 - mx), e1 = __expf(l1 - mx), e2 = __expf(l2 - mx); const float inv = 1.f / (e0 + e1 + e2);
        const u32x2 a = *(const u32x2*)(OB + (size_t)row * 768 + hg * 64 + c), bb = *(const u32x2*)(OB + (size_t)row * 768 + 256 + hg * 64 + c), cc = *(const u32x2*)(OB + (size_t)row * 768 + 512 + hg * 64 + c);
        const float a0 = e0 * inv, a1 = e1 * inv, a2 = e2 * inv; u32x2 o;
        o.x = pk2(a0 * bf_lo(a.x) + a1 * bf_lo(bb.x) + a2 * bf_lo(cc.x), a0 * bf_hi(a.x) + a1 * bf_hi(bb.x) + a2 * bf_hi(cc.x));
        o.y = pk2(a0 * bf_lo(a.y) + a1 * bf_lo(bb.y) + a2 * bf_lo(cc.y), a0 * bf_hi(a.y) + a1 * bf_hi(bb.y) + a2 * bf_hi(cc.y));
        *(u32x2*)(OBC + (size_t)row * 256 + hg * 64 + c) = o; }
}
__device__ __forceinline__ void ln_rows(float* Z, const float* g, const float* bta, bf16* OB16, int gw, int NGW, int lane) {
    f32x4 gv[4], bv[4];
#pragma unroll
    for (int j = 0; j < 4; ++j) { gv[j] = ((const f32x4*)g)[lane + 64 * j]; bv[j] = ((const f32x4*)bta)[lane + 64 * j]; }
    for (int row0 = gw; row0 < M; row0 += 2 * NGW) {
        f32x4 v[2][4]; float s[2] = {0.f, 0.f}; f32x4* zr[2];
#pragma unroll
        for (int r = 0; r < 2; ++r) { const int row = row0 + r * NGW; zr[r] = (f32x4*)(Z + (size_t)(row < M ? row : row0) * DM) + lane;
#pragma unroll
            for (int j = 0; j < 4; ++j) v[r][j] = zr[r][64 * j]; }
#pragma unroll
        for (int r = 0; r < 2; ++r) {
#pragma unroll
            for (int j = 0; j < 4; ++j) s[r] += (v[r][j][0] + v[r][j][1]) + (v[r][j][2] + v[r][j][3]); }
        const float mean0 = wave_sum(s[0]) * (1.f / DM), mean1 = wave_sum(s[1]) * (1.f / DM); float s2[2] = {0.f, 0.f};
#pragma unroll
        for (int r = 0; r < 2; ++r) { const float mean = r ? mean1 : mean0;
#pragma unroll
            for (int j = 0; j < 4; ++j) { v[r][j] = v[r][j] - mean; s2[r] += (v[r][j][0] * v[r][j][0] + v[r][j][1] * v[r][j][1]) + (v[r][j][2] * v[r][j][2] + v[r][j][3] * v[r][j][3]); } }
        const float rs0 = 1.f / sqrtf(wave_sum(s2[0]) * (1.f / DM) + 1e-5f), rs1 = 1.f / sqrtf(wave_sum(s2[1]) * (1.f / DM) + 1e-5f);
#pragma unroll
        for (int r = 0; r < 2; ++r) { const int row = row0 + r * NGW; if (row < M) { const float rstd = r ? rs1 : rs0;
#pragma unroll
            for (int j = 0; j < 4; ++j) { const f32x4 y = v[r][j] * rstd * gv[j] + bv[j]; zr[r][64 * j] = y;
                if (OB16) { u32x2 w; w.x = pk2(y[0], y[1]); w.y = pk2(y[2], y[3]); *((u32x2*)(OB16 + (size_t)row * DM) + lane + 64 * j) = w; } } } }
    }
}

__global__ void __launch_bounds__(NTHR, 2) fwd_megakernel(Args args) {
    extern __shared__ __attribute__((aligned(16))) unsigned char lds_raw[];
    LAS unsigned char* lds = (LAS unsigned char*)lds_raw;
    const int tid = threadIdx.x, lane = tid & 63, wid = __builtin_amdgcn_readfirstlane(tid >> 6);
    const int G = gridDim.x, blk = blockIdx.x, gw = blk * NWAVES + wid, NGW = G * NWAVES;
    unsigned char* ws = args.ws;
    const int lo = args.ph_lo, hi = args.ph_hi;
#ifndef PH_MASK
#define PH_MASK 0xFFFF
#endif
#define IN(k) (((PH_MASK >> (k)) & 1) && lo <= (k) && (k) < hi)
#define SEAM(k) do { if (IN(k) && IN((k) + 1)) { cg::this_grid().sync(); } } while (0)
    using namespace pg8;
    if (IN(0)) { p0_prologue(args, lds, gw, NGW, wid, lane); }
    SEAM(0);
    if (IN(1)) {
        { Gemm g{(const bf16_t*)(ws + WS_XB), (const bf16_t*)(ws + WS_WIN), M, NPROJ, DM}; StaticOrder S; S.init(M, NPROJ, G, blk);
          EpiProj E{(bf16_t*)(ws + WS_QA), (bf16_t*)(ws + WS_KA), (bf16_t*)(ws + WS_QB), (bf16_t*)(ws + WS_KB), (bf16_t*)(ws + WS_QI), (bf16_t*)(ws + WS_KIWI), (const float*)(ws + WS_CS)};
          gemm_phase<EpiProj, StaticOrder, true, true>(lds, g, S, E); }
        { Gemm g{(const bf16_t*)(ws + WS_WV), (const bf16_t*)(ws + WS_XB), NVT, M, DM}; StaticOrder S; S.init(NVT, M, G, blk);
          EpiBf16 E{(bf16_t*)(ws + WS_VAT), (bf16_t*)(ws + WS_VBT), M};
          gemm_phase<EpiBf16, StaticOrder, true, true>(lds, g, S, E); }
    }
    SEAM(1);
    if (IN(2)) indexer_phase(lds, (const bf16*)(ws + WS_QI), (const bf16*)(ws + WS_KIWI), (u64*)(ws + WS_MASK), blk, G, wid, lane);
    SEAM(2);
#ifdef PROBE_ATT
    if (IN(3)) { attn_phase(lds, ws, (unsigned*)(ws + WS_CTL) + 128, tid, wid, lane, true); cg::this_grid().sync(); }
#endif
#ifdef PROBE_IDX
    if (IN(3)) { indexer_phase(lds, (const bf16*)(ws + WS_QI), (const bf16*)(ws + WS_KIWI), (u64*)(ws + WS_MASK), blk, G, wid, lane); cg::this_grid().sync(); }
#endif
    if (IN(3)) attn_phase(lds, ws, (unsigned*)(ws + WS_CTL) + 64, tid, wid, lane);
    SEAM(3);
    if (IN(4)) {
        combine_b(ws, gw, NGW, lane);
        Gemm g{(const bf16_t*)(ws + WS_XB), (const bf16_t*)(ws + WS_WGATE), M, NGATE, DM}; StaticOrder S; S.init(M, NGATE, G, blk);
        EpiGate E{(bf16_t*)(ws + WS_GATE), NGATE, args.in[3]};
        gemm_phase<EpiGate, StaticOrder, true, true>(lds, g, S, E);
    }
    SEAM(4);
    if (IN(5)) {
        { Gemm g{(const bf16_t*)(ws + WS_QA), (const bf16_t*)(ws + WS_WA), M, DM, 768}; StaticOrder S; S.init(M, DM, G, blk);
          EpiBrA E{args.out, (const bf16_t*)(ws + WS_GATE)};
          gemm_phase<EpiBrA, StaticOrder, true, true>(lds, g, S, E); }
        { Gemm g{(const bf16_t*)(ws + WS_OBC), (const bf16_t*)(ws + WS_WB), M, DM, 256}; StaticOrder S; S.init(M, DM, G, blk);
          EpiBrB E{args.out, (const bf16_t*)(ws + WS_GATE), (bf16_t*)(ws + WS_MIXED)};
          gemm_phase<EpiBrB, StaticOrder, true, true>(lds, g, S, E); }
    }
    SEAM(5);
    if (IN(6)) {
        Gemm g{(const bf16_t*)(ws + WS_MIXED), (const bf16_t*)(ws + WS_WO), M, DM, DM}; StaticOrder S; S.init(M, DM, G, blk);
        EpiRes E{args.in[0], args.out};
        gemm_phase<EpiRes, StaticOrder, true, true>(lds, g, S, E);
    }
    SEAM(6);
    if (IN(7)) ln_rows(args.out, args.in[7], args.in[8], (bf16*)(ws + WS_X1B), gw, NGW, lane);
    SEAM(7);
    if (IN(8)) {
        Gemm g{(const bf16_t*)(ws + WS_X1B), (const bf16_t*)(ws + WS_WGU), M, NGU, DM}; StaticOrder S; S.init(M, NGU, G, blk);
        EpiSwiGLU E{(bf16_t*)(ws + WS_H)};
        gemm_phase<EpiSwiGLU, StaticOrder, true, true>(lds, g, S, E);
    }
    SEAM(8);
    if (IN(9)) {
        Gemm g{(const bf16_t*)(ws + WS_H), (const bf16_t*)(ws + WS_WD), M, DM, FFN}; StaticOrder S; S.init(M, DM, G, blk);
        EpiRes E{args.out, args.out};
        gemm_phase<EpiRes, StaticOrder, true, true>(lds, g, S, E);
    }
    SEAM(9);
    if (IN(10)) ln_rows(args.out, args.in[12], args.in[13], nullptr, gw, NGW, lane);
#undef IN
#undef SEAM
}

constexpr int NPHASE = 11;
extern "C" void kernel_launch(void* const* d_in, const int* in_sizes, int n_in, void* d_out, int out_size, void* d_ws, size_t ws_size, hipStream_t stream) {
    static int grid = 0;
    if (grid == 0) {
        if (n_in != 14 || in_sizes[0] != M * DM || out_size != M * DM || ws_size < WS_END) { fprintf(stderr, "kernel_launch: unexpected shapes / workspace (n_in %d, ws %zu); nothing launched\n", n_in, ws_size); grid = -1; return; }
        int dev = 0, cus = 0, per_cu = 0;
        if (hipGetDevice(&dev) != hipSuccess || hipDeviceGetAttribute(&cus, hipDeviceAttributeMultiprocessorCount, dev) != hipSuccess) { grid = -1; return; }
        if (hipFuncSetAttribute((const void*)fwd_megakernel, hipFuncAttributeMaxDynamicSharedMemorySize, LDS_BYTES) != hipSuccess) { fprintf(stderr, "kernel_launch: hipFuncSetAttribute failed\n"); grid = -1; return; }
        if (hipOccupancyMaxActiveBlocksPerMultiprocessor(&per_cu, (const void*)fwd_megakernel, NTHR, LDS_BYTES) != hipSuccess || per_cu < 1) { fprintf(stderr, "kernel_launch: occupancy query says %d\n", per_cu); per_cu = 1; }
        (void)hipGetLastError();
        grid = cus * per_cu;
    }
    if (grid < 0) return;
    (void)hipMemsetAsync((char*)d_ws + WS_CTL, 0, 4096, stream);
    Args a{};
    for (int i = 0; i < 14; ++i) a.in[i] = (const float*)d_in[i];
    a.out = (float*)d_out; a.ws = (unsigned char*)d_ws;
#if MK_N_LAUNCHES == 1
    a.ph_lo = 0; a.ph_hi = NPHASE;
    void* kargs[] = {&a};
    hipError_t e = hipLaunchCooperativeKernel((const void*)fwd_megakernel, dim3(grid), dim3(NTHR), kargs, LDS_BYTES, stream);
    if (e != hipSuccess) fprintf(stderr, "cooperative launch failed: %s (grid %d)\n", hipGetErrorString(e), grid);
#else
    for (int p = 0; p < NPHASE; ++p) { a.ph_lo = p; a.ph_hi = p + 1; hipLaunchKernelGGL(fwd_megakernel, dim3(grid), dim3(NTHR), LDS_BYTES, stream, a); }
#endif
}
```

```cpp
#include <hip/hip_runtime.h>
#include <hip/hip_cooperative_groups.h>
#include <cstdio>
#include <cstdint>
namespace cg = cooperative_groups;
#ifndef MK_N_LAUNCHES
#define MK_N_LAUNCHES 1
#endif
constexpr float C2 = 0.125f * 1.4426950408889634f;
constexpr float DN_ALPHA = 1.1892071150027210f;
namespace pg8 {
#define PG8_LAS __attribute__((address_space(3)))
typedef unsigned short bf16_t;
typedef short bf16x8 __attribute__((ext_vector_type(8)));
typedef float f32x4 __attribute__((ext_vector_type(4)));
typedef unsigned u32x4 __attribute__((ext_vector_type(4)));
constexpr int BM = 256, BK = 64, HALF = 128, HTB = HALF * BK * 2  , STAGE_BYTES = 8 * HTB, NXCD = 8, WGM = 8;

__host__ __device__ __forceinline__ int lds_byte(int r, int c) { const int st = (r >> 4) * 2 + (c >> 5), rr = r & 15, cc = c & 31, ob = rr * 64 + cc * 2; return st * 1024 + (ob ^ (((ob >> 9) & 1) << 5)); }
__host__ __device__ __forceinline__ void stage_rc(int b, int& R, int& C) { const int st = b / 1024, sb = b % 1024, swz = sb ^ (((sb >> 9) & 1) << 5); R = (st >> 1) * 16 + swz / 64; C = (st & 1) * 32 + (swz % 64) / 2; }
__host__ __device__ __forceinline__ int perm32(int rho) { const int n = rho >> 4, i = rho & 15; return 8 * (i >> 2) + 4 * n + (i & 3); }

struct Unit { int pm, pn; };
struct Gemm { const bf16_t* A; const bf16_t* Bt; int M, N, K; };

struct StaticOrder {
    int nM, nN, nwg, G, c;
    __host__ __device__ void init(int M, int N, int G_, int c_) { nM = M / BM; nN = N / BM; nwg = nM * nN; G = G_; c = c_; }
    __host__ __device__ bool next(int i, Unit& u) const {
        const long L = (long)i * G + c; if (L >= nwg) return false;
        int wgid = (int)L; { const int q = nwg / NXCD, r = nwg % NXCD, xcd = wgid % NXCD, off = wgid / NXCD; wgid = (xcd < r ? xcd * (q + 1) : r * (q + 1) + (xcd - r) * q) + off; }
        const int nig = WGM * nN, gid = wgid / nig, fm = gid * WGM, gsz = (nM - fm) < WGM ? (nM - fm) : WGM;
        u.pm = fm + ((wgid % nig) % gsz); u.pn = (wgid % nig) / gsz; return true;
    }
    __device__ __forceinline__ void a_ready(const Unit&) const {}
    __device__ __forceinline__ void done(const Unit&) const {}
};

typedef float f32x2_cv __attribute__((ext_vector_type(2))); typedef __bf16 bf16x2_cv __attribute__((ext_vector_type(2)));
__device__ __forceinline__ unsigned cvt_pk_bf16(float lo, float hi) { f32x2_cv v = {lo, hi}; bf16x2_cv b = __builtin_convertvector(v, bf16x2_cv); return __builtin_bit_cast(unsigned, b); }
__device__ __forceinline__ u32x4 pack8(f32x4 a, f32x4 b) { u32x4 w; w.x = cvt_pk_bf16(a[0], a[1]); w.y = cvt_pk_bf16(a[2], a[3]); w.z = cvt_pk_bf16(b[0], b[1]); w.w = cvt_pk_bf16(b[2], b[3]); return w; }
__device__ __forceinline__ void unpack8(u32x4 w, f32x4& a, f32x4& b) {
    a[0] = __uint_as_float(w.x << 16); a[1] = __uint_as_float(w.x & 0xffff0000u); a[2] = __uint_as_float(w.y << 16); a[3] = __uint_as_float(w.y & 0xffff0000u);
    b[0] = __uint_as_float(w.z << 16); b[1] = __uint_as_float(w.z & 0xffff0000u); b[2] = __uint_as_float(w.w << 16); b[3] = __uint_as_float(w.w & 0xffff0000u); }
#define EPI_LOOP_AM _Pragma("unroll") for (int ai = 0; ai < 2; ++ai) _Pragma("unroll") for (int m = 0; m < 4; ++m)
#define EPI_ROW (u.pm * BM + ai * HALF + wr * 64 + m * 16 + fr)
#define EPI_COL(bj) (u.pn * BM + (bj) * HALF + wc * 32 + 8 * fq)

struct EpiBf16 { static constexpr bool PERM = true, AFTER_DRAIN = false; bf16_t* O0; bf16_t* O1; int ldc;
    __device__ __forceinline__ void operator()(const f32x4 (&acc)[2][2][4][2], const Unit& u, int wr, int wc, int fr, int fq) const {
        bf16_t* O = u.pm < 3 ? O0 : O1 - (size_t)768 * ldc;
        EPI_LOOP_AM { const size_t row = EPI_ROW;
#pragma unroll
            for (int bj = 0; bj < 2; ++bj) *(u32x4*)(O + row * ldc + EPI_COL(bj)) = pack8(acc[ai][bj][m][0], acc[ai][bj][m][1]); } }
};
struct EpiProj { static constexpr bool PERM = true, AFTER_DRAIN = false;
    bf16_t *QA, *KA, *QB, *KB, *QI, *KIWI; const float* cs;
    __device__ __forceinline__ void operator()(const f32x4 (&acc)[2][2][4][2], const Unit& u, int wr, int wc, int fr, int fq) const {
        const int pn = u.pn; bf16_t* dst; int ldc, colt; float sc = 1.f;
        if (pn < 3) { dst = QA; ldc = 768; colt = 256 * pn; sc = C2; } else if (pn < 6) { dst = KA; ldc = 768; colt = 256 * (pn - 3); }
        else if (pn < 9) { dst = QB; ldc = 768; colt = 256 * (pn - 6); sc = C2; } else if (pn < 12) { dst = KB; ldc = 768; colt = 256 * (pn - 9); }
        else if (pn < 14) { dst = QI; ldc = 512; colt = 256 * (pn - 12); } else { dst = KIWI; ldc = 128; colt = 0; }
        const bool last = pn == 14, ropeLane = ((wc & 1) == 0) && fq < 2; const float sgn = fq == 0 ? -1.f : 1.f;
        EPI_LOOP_AM { const size_t row = EPI_ROW;
            f32x4 c0 = {0, 0, 0, 0}, c1 = c0, s0 = c0, s1 = c0;
            if (ropeLane) { const f32x4* p = (const f32x4*)(cs + row * 16); c0 = p[0]; c1 = p[1]; s0 = p[2]; s1 = p[3]; }
#pragma unroll
            for (int bj = 0; bj < 2; ++bj) { f32x4 v0 = acc[ai][bj][m][0], v1 = acc[ai][bj][m][1], p0, p1;
#pragma unroll
                for (int k = 0; k < 4; ++k) { p0[k] = __shfl_xor(v0[k], 16); p1[k] = __shfl_xor(v1[k], 16); }
                const bool doRope = ropeLane && (!last || (bj == 0 && wc == 0));
                if (doRope) { v0 = v0 * c0 + (sgn * p0) * s0; v1 = v1 * c1 + (sgn * p1) * s1; }
                v0 = v0 * sc; v1 = v1 * sc;
                if (!last) *(u32x4*)(dst + row * ldc + colt + bj * HALF + wc * 32 + 8 * fq) = pack8(v0, v1);
                else if (bj == 0) { const int c = wc * 32 + 8 * fq;
                    if (c < 64) *(u32x4*)(KIWI + ((((row >> 5) * 4 + (c >> 4)) * 2 + ((c >> 3) & 1)) * 32 + (row & 31)) * 8) = pack8(v0, v1);
                    else if (c == 64) *(u32x4*)(KIWI + (size_t)2097152 + row * 8) = pack8(v0, v1); } } } }
};
struct EpiGate { static constexpr bool PERM = true, AFTER_DRAIN = false; bf16_t* O; int ldc; const float* bias;
    __device__ __forceinline__ void operator()(const f32x4 (&acc)[2][2][4][2], const Unit& u, int wr, int wc, int fr, int fq) const {
        f32x4 bv[2][2];
#pragma unroll
        for (int bj = 0; bj < 2; ++bj) { bv[bj][0] = *(const f32x4*)(bias + EPI_COL(bj)); bv[bj][1] = *(const f32x4*)(bias + EPI_COL(bj) + 4); }
        EPI_LOOP_AM { const size_t row = EPI_ROW;
#pragma unroll
            for (int bj = 0; bj < 2; ++bj) { f32x4 v[2];
#pragma unroll
                for (int n = 0; n < 2; ++n) { const f32x4 x = acc[ai][bj][m][n] + bv[bj][n];
#pragma unroll
                    for (int k = 0; k < 4; ++k) v[n][k] = __builtin_amdgcn_rcpf(1.f + __expf(-x[k])); }
                *(u32x4*)(O + row * ldc + EPI_COL(bj)) = pack8(v[0], v[1]); } } }
};
struct EpiBrA { static constexpr bool PERM = true, AFTER_DRAIN = false; float* T; const bf16_t* G;
    __device__ __forceinline__ void operator()(const f32x4 (&acc)[2][2][4][2], const Unit& u, int wr, int wc, int fr, int fq) const {
        EPI_LOOP_AM { const size_t row = EPI_ROW;
#pragma unroll
            for (int bj = 0; bj < 2; ++bj) { const int col = EPI_COL(bj); f32x4 g0, g1; unpack8(*(const u32x4*)(G + row * 2048 + col), g0, g1);
                *(f32x4*)(T + row * 1024 + col) = g0 * acc[ai][bj][m][0]; *(f32x4*)(T + row * 1024 + col + 4) = g1 * acc[ai][bj][m][1]; } } }
};
struct EpiBrB { static constexpr bool PERM = true, AFTER_DRAIN = false; const float* T; const bf16_t* G; bf16_t* O;
    __device__ __forceinline__ void operator()(const f32x4 (&acc)[2][2][4][2], const Unit& u, int wr, int wc, int fr, int fq) const {
        EPI_LOOP_AM { const size_t row = EPI_ROW;
#pragma unroll
            for (int bj = 0; bj < 2; ++bj) { const int col = EPI_COL(bj); f32x4 g0, g1; unpack8(*(const u32x4*)(G + row * 2048 + 1024 + col), g0, g1);
                const f32x4 t0 = *(const f32x4*)(T + row * 1024 + col), t1 = *(const f32x4*)(T + row * 1024 + col + 4);
                *(u32x4*)(O + row * 1024 + col) = pack8(t0 + g0 * acc[ai][bj][m][0], t1 + g1 * acc[ai][bj][m][1]); } } }
};
struct EpiRes { static constexpr bool PERM = true, AFTER_DRAIN = false; const float* R; float* Z;
    __device__ __forceinline__ void operator()(const f32x4 (&acc)[2][2][4][2], const Unit& u, int wr, int wc, int fr, int fq) const {
        EPI_LOOP_AM { const size_t row = EPI_ROW;
#pragma unroll
            for (int bj = 0; bj < 2; ++bj) { const int col = EPI_COL(bj);
                const f32x4 r0 = *(const f32x4*)(R + row * 1024 + col), r1 = *(const f32x4*)(R + row * 1024 + col + 4);
                *(f32x4*)(Z + row * 1024 + col) = r0 * DN_ALPHA + acc[ai][bj][m][0]; *(f32x4*)(Z + row * 1024 + col + 4) = r1 * DN_ALPHA + acc[ai][bj][m][1]; } } }
};
struct EpiSwiGLU { static constexpr bool PERM = true, AFTER_DRAIN = false; bf16_t* H;
    __device__ __forceinline__ void operator()(const f32x4 (&acc)[2][2][4][2], const Unit& u, int wr, int wc, int fr, int fq) const {
        EPI_LOOP_AM { const size_t row = EPI_ROW; f32x4 v[2];
#pragma unroll
            for (int n = 0; n < 2; ++n) { const f32x4 g = acc[ai][0][m][n], up = acc[ai][1][m][n];
#pragma unroll
                for (int k = 0; k < 4; ++k) v[n][k] = g[k] * __builtin_amdgcn_rcpf(1.f + __expf(-g[k])) * up[k]; }
            *(u32x4*)(H + row * 2816 + u.pn * HALF + wc * 32 + 8 * fq) = pack8(v[0], v[1]); } }
};
template <class Epi, class Sched, bool ALIGN_EPI = false, bool SP2 = false>
__device__ __forceinline__ void gemm_phase(PG8_LAS unsigned char* lds, const Gemm g, const Sched& S, const Epi& E) {
    const int tid = threadIdx.x, wid = __builtin_amdgcn_readfirstlane(tid >> 6), lane = tid & 63, wr = wid >> 2, wc = wid & 3, fr = lane & 15, fq = lane >> 4;
    const int K = g.K, nt = K / BK;
    unsigned voffA[2], voffB[2];
#pragma unroll
    for (int i = 0; i < 2; ++i) { int R, C; stage_rc(tid * 16 + i * 8192, R, C); const int Rb = Epi::PERM ? ((R & ~31) + perm32(R & 31)) : R;
        voffA[i] = (unsigned)(R * K + C) * 2u; voffB[i] = (unsigned)(Rb * K + C) * 2u; }
    const size_t kstep = (size_t)(BK * 2);
    const size_t hstep = (size_t)HALF * K * 2;
    const size_t tstep = 2 * hstep;
    const unsigned ldsw = (unsigned)wid * 1024u;
    const int aoff = lds_byte(wr * 64 + fr, fq * 8), boff = lds_byte(wc * 32 + fr, fq * 8);
#define PG8_SA(b, h) (((b) * 2 + (h)) * HTB)
#define PG8_SB(b, h) ((4 + (b) * 2 + (h)) * HTB)
#define PG8_STAGE(bufoff, gbase, voff) do { _Pragma("unroll") for (int _i = 0; _i < 2; ++_i) \
        __builtin_amdgcn_global_load_lds((const unsigned*)((const char*)(gbase) + (voff)[_i]), (PG8_LAS unsigned*)(lds + (bufoff) + ldsw + _i * 8192), 16, 0, 0); } while (0)
#define PG8_LDA(dst, b, h) do { _Pragma("unroll") for (int m = 0; m < 4; ++m) _Pragma("unroll") for (int k = 0; k < 2; ++k) dst[m][k] = *(const PG8_LAS bf16x8*)(lds + PG8_SA(b, h) + aoff + m * 2048 + k * 1024); } while (0)
#define PG8_LDB(dst, b, h) do { _Pragma("unroll") for (int n = 0; n < 2; ++n) _Pragma("unroll") for (int k = 0; k < 2; ++k) dst[n][k] = *(const PG8_LAS bf16x8*)(lds + PG8_SB(b, h) + boff + n * 2048 + k * 1024); } while (0)
#define PG8_MMA(ai, bj, At, Bt) do { __builtin_amdgcn_s_setprio(1); _Pragma("unroll") for (int m = 0; m < 4; ++m) _Pragma("unroll") for (int n = 0; n < 2; ++n) _Pragma("unroll") for (int k = 0; k < 2; ++k) \
        acc[ai][bj][m][n] = __builtin_amdgcn_mfma_f32_16x16x32_bf16(Bt[n][k], At[m][k], acc[ai][bj][m][n], 0, 0, 0); __builtin_amdgcn_s_setprio(0); } while (0)
#define PG8_WAIT_V(n) asm volatile("s_waitcnt vmcnt(" #n ")" ::: "memory")
#define PG8_WAIT_L(n) asm volatile("s_waitcnt lgkmcnt(" #n ")" ::: "memory")
#define PG8_BAR __builtin_amdgcn_s_barrier()
#define PG8_SCHED __builtin_amdgcn_sched_barrier(0)
    Unit cur, nxt; int ui = 0;
    if (!S.next(0, cur)) return;
    f32x4 acc[2][2][4][2];
#pragma unroll
    for (int a = 0; a < 2; ++a)
#pragma unroll
        for (int b = 0; b < 2; ++b)
#pragma unroll
            for (int m = 0; m < 4; ++m)
#pragma unroll
                for (int n = 0; n < 2; ++n) acc[a][b][m][n] = (f32x4){0.f, 0.f, 0.f, 0.f};
    bf16x8 At[4][2], B0[2][2], B1[2][2];
    const char* cA = (const char*)g.A + (size_t)cur.pm * tstep; const char* cB = (const char*)g.Bt + (size_t)cur.pn * tstep;
    S.a_ready(cur);
    if constexpr (SP2) {
        PG8_STAGE(PG8_SB(0, 0), cB, voffB); PG8_STAGE(PG8_SB(0, 1), cB + hstep, voffB); PG8_STAGE(PG8_SA(0, 0), cA, voffA); PG8_STAGE(PG8_SA(0, 1), cA + hstep, voffA);
        if (wr == 1) PG8_BAR;
        PG8_WAIT_V(2); PG8_BAR;
        PG8_STAGE(PG8_SB(1, 0), cB + kstep, voffB); PG8_STAGE(PG8_SA(1, 0), cA + kstep, voffA); PG8_STAGE(PG8_SB(1, 1), cB + hstep + kstep, voffB);
        PG8_WAIT_V(6); PG8_BAR;
    } else {
        PG8_STAGE(PG8_SB(0, 0), cB, voffB); PG8_STAGE(PG8_SA(0, 0), cA, voffA); PG8_STAGE(PG8_SB(0, 1), cB + hstep, voffB); PG8_STAGE(PG8_SA(0, 1), cA + hstep, voffA);
        if (wr == 1) PG8_BAR;
        PG8_WAIT_V(4); PG8_BAR;
        PG8_STAGE(PG8_SB(1, 0), cB + kstep, voffB); PG8_STAGE(PG8_SA(1, 0), cA + kstep, voffA); PG8_STAGE(PG8_SB(1, 1), cB + hstep + kstep, voffB);
        PG8_WAIT_V(6); PG8_BAR;
    }
    for (;;) {
        const bool has_next = S.next(ui + 1, nxt);
        const char* nA = has_next ? (const char*)g.A + (size_t)nxt.pm * tstep : cA; const char* nB = has_next ? (const char*)g.Bt + (size_t)nxt.pn * tstep : cB;
        for (int t = 0; t < nt; t += 2) {
            const bool last = (t == nt - 2);
            const char* a1 = cA + (size_t)(t + 1) * kstep;
            const char* a2 = last ? nA : cA + (size_t)(t + 2) * kstep; const char* b2 = last ? nB : cB + (size_t)(t + 2) * kstep;
            const char* a3 = a2 + kstep; const char* b3 = b2 + kstep;
            if (last && has_next) S.a_ready(nxt);
            if constexpr (SP2) {
            PG8_LDB(B0, 0, 0); PG8_LDB(B1, 0, 1); PG8_SCHED; PG8_LDA(At, 0, 0); PG8_STAGE(PG8_SA(1, 1), a1 + hstep, voffA);
            PG8_WAIT_V(8); PG8_WAIT_L(0); PG8_BAR; PG8_MMA(0, 0, At, B0); PG8_MMA(0, 1, At, B1); PG8_BAR; PG8_SCHED;
            PG8_LDA(At, 0, 1); PG8_STAGE(PG8_SB(0, 0), b2, voffB); PG8_STAGE(PG8_SB(0, 1), b2 + hstep, voffB); PG8_STAGE(PG8_SA(0, 0), a2, voffA);
            PG8_WAIT_V(8); PG8_WAIT_L(0); PG8_BAR; PG8_MMA(1, 0, At, B0); PG8_MMA(1, 1, At, B1); PG8_BAR; PG8_SCHED;
            PG8_LDB(B0, 1, 0); PG8_LDB(B1, 1, 1); PG8_SCHED; PG8_LDA(At, 1, 0); PG8_STAGE(PG8_SA(0, 1), a2 + hstep, voffA);
            PG8_WAIT_V(8); PG8_WAIT_L(0); PG8_BAR; PG8_MMA(0, 0, At, B0); PG8_MMA(0, 1, At, B1); PG8_BAR; PG8_SCHED;
            PG8_LDA(At, 1, 1); PG8_STAGE(PG8_SB(1, 0), b3, voffB); PG8_STAGE(PG8_SB(1, 1), b3 + hstep, voffB); PG8_STAGE(PG8_SA(1, 0), a3, voffA);
            PG8_WAIT_V(8); PG8_WAIT_L(0); PG8_BAR; PG8_MMA(1, 0, At, B0); PG8_MMA(1, 1, At, B1); PG8_BAR; PG8_SCHED;
            } else {
            PG8_LDB(B0, 0, 0); PG8_SCHED; PG8_LDA(At, 0, 0); PG8_STAGE(PG8_SA(1, 1), a1 + hstep, voffA);
            PG8_WAIT_L(8); PG8_BAR; PG8_WAIT_L(0); PG8_MMA(0, 0, At, B0); PG8_BAR; PG8_SCHED;
            PG8_LDB(B1, 0, 1); PG8_STAGE(PG8_SB(0, 0), b2, voffB);
            PG8_BAR; PG8_WAIT_L(0); PG8_MMA(0, 1, At, B1); PG8_BAR;
            PG8_LDA(At, 0, 1); PG8_STAGE(PG8_SA(0, 0), a2, voffA);
            PG8_BAR; PG8_WAIT_L(0); PG8_MMA(1, 0, At, B0); PG8_BAR; PG8_SCHED;
            PG8_STAGE(PG8_SB(0, 1), b2 + hstep, voffB);
            PG8_WAIT_V(6); PG8_BAR; PG8_MMA(1, 1, At, B1); PG8_BAR;
            PG8_LDB(B0, 1, 0); PG8_SCHED; PG8_LDA(At, 1, 0); PG8_STAGE(PG8_SA(0, 1), a2 + hstep, voffA);
            PG8_WAIT_L(8); PG8_BAR; PG8_WAIT_L(0); PG8_MMA(0, 0, At, B0); PG8_BAR; PG8_SCHED;
            PG8_LDB(B1, 1, 1); PG8_STAGE(PG8_SB(1, 0), b3, voffB);
            PG8_BAR; PG8_WAIT_L(0); PG8_MMA(0, 1, At, B1); PG8_BAR;
            PG8_LDA(At, 1, 1); PG8_STAGE(PG8_SA(1, 0), a3, voffA);
            PG8_BAR; PG8_WAIT_L(0); PG8_MMA(1, 0, At, B0); PG8_BAR; PG8_SCHED;
            PG8_STAGE(PG8_SB(1, 1), b3 + hstep, voffB);
            PG8_WAIT_V(6); PG8_BAR; PG8_MMA(1, 1, At, B1); PG8_BAR;
            }
        }
        if constexpr (ALIGN_EPI) { if (wr == 0) PG8_BAR; }
        if constexpr (!Epi::AFTER_DRAIN) { E(acc, cur, wr, wc, fr, fq); S.done(cur); }
        if (!has_next) break;
#pragma unroll
        for (int a = 0; a < 2; ++a)
#pragma unroll
            for (int b = 0; b < 2; ++b)
#pragma unroll
                for (int m = 0; m < 4; ++m)
#pragma unroll
                    for (int n = 0; n < 2; ++n) acc[a][b][m][n] = (f32x4){0.f, 0.f, 0.f, 0.f};
        cur = nxt; cA = nA; cB = nB; ++ui;
        if constexpr (ALIGN_EPI) { if (wr == 1) PG8_BAR; }
    }
    PG8_WAIT_V(0);
    if constexpr (!ALIGN_EPI) { if (wr == 0) PG8_BAR; }
    PG8_BAR;
    if constexpr (Epi::AFTER_DRAIN) { E.fused(acc, cur, wr, wc, fr, fq, lds, wid, lane); S.done(cur); }
#undef PG8_SA
#undef PG8_SB
#undef PG8_STAGE
#undef PG8_LDA
#undef PG8_LDB
#undef PG8_MMA
#undef PG8_WAIT_V
#undef PG8_WAIT_L
#undef PG8_BAR
#undef PG8_SCHED
}
}
#define LAS __attribute__((address_space(3)))
typedef unsigned short bf16;
typedef short bf16x8 __attribute__((ext_vector_type(8)));
typedef float f32x4 __attribute__((ext_vector_type(4)));
typedef float f32x16 __attribute__((ext_vector_type(16)));
typedef unsigned u32x4 __attribute__((ext_vector_type(4)));
typedef unsigned u32x2 __attribute__((ext_vector_type(2)));
typedef unsigned long long u64;
constexpr int NWAVES = 8, NTHR = 512;
constexpr int BATCH = 8, SEQ = 4096, DM = 1024, M = BATCH * SEQ, FFN = 2816;
constexpr int NPROJ = 3840, NVT = 1536, NGATE = 2048, NGU = 5632;
constexpr size_t MiB = 1u << 20;
constexpr size_t WS_CTL = 0;
constexpr size_t WS_WIN = 1 * MiB, WS_WV = WS_WIN + (size_t)NPROJ * DM * 2, WS_WGATE = WS_WV + (size_t)NVT * DM * 2, WS_WA = WS_WGATE + (size_t)NGATE * DM * 2,
                 WS_WB = WS_WA + (size_t)DM * 768 * 2, WS_WO = WS_WB + (size_t)DM * 256 * 2, WS_WGU = WS_WO + (size_t)DM * DM * 2, WS_WD = WS_WGU + (size_t)NGU * DM * 2,
                 WS_WEND = WS_WD + (size_t)DM * FFN * 2;
static_assert(WS_WEND <= 36 * MiB, "weights");
constexpr size_t WS_CS = 36 * MiB, WS_MASK = 38 * MiB, WS_XB = 54 * MiB, WS_QA = 118 * MiB, WS_KA = 166 * MiB, WS_VAT = 214 * MiB, WS_QB = 262 * MiB, WS_KB = 310 * MiB,
                 WS_VBT = 358 * MiB, WS_QI = 406 * MiB, WS_KIWI = 438 * MiB, WS_LSE = 446 * MiB, WS_OBC = 448 * MiB, WS_END = 464 * MiB;
constexpr size_t WS_GATE = 310 * MiB  , WS_MIXED = 166 * MiB  , WS_X1B = 54 * MiB  , WS_H = 118 * MiB  ;
static_assert(WS_H + (size_t)M * FFN * 2 <= WS_GATE + 128 * MiB, "map");
constexpr int LDS_BYTES = 147456;
constexpr int SCP = 4128;

__device__ __forceinline__ unsigned f2bf(float f) { unsigned u = __builtin_bit_cast(unsigned, f); return (u + 0x7fffu + ((u >> 16) & 1u)) >> 16; }
__device__ __forceinline__ unsigned pk2(float lo, float hi) { return f2bf(lo) | (f2bf(hi) << 16); }
__device__ __forceinline__ float bf_lo(unsigned w) { return __uint_as_float(w << 16); }
__device__ __forceinline__ float bf_hi(unsigned w) { return __uint_as_float(w & 0xffff0000u); }
__device__ __forceinline__ float wave_sum(float v) {
#pragma unroll
    for (int o = 1; o < 64; o <<= 1) v += __shfl_xor(v, o);
    return v; }

struct Args { const float* in[14]; float* out; unsigned char* ws; int ph_lo, ph_hi; };

__device__ __forceinline__ void tr_item(const float* W, int ld, int K, int c0, int nvalid, bf16* WT, int r0, int k0, LAS float* scr, int lane) {
    float tv[32];
#pragma unroll
    for (int i = 0; i < 32; ++i) { const int kk = 2 * i + (lane >> 5), n = lane & 31; tv[i] = (n < nvalid) ? W[(size_t)(k0 + kk) * ld + c0 + n] : 0.f; }
#pragma unroll
    for (int i = 0; i < 32; ++i) { const int kk = 2 * i + (lane >> 5), n = lane & 31; scr[kk * 33 + n] = tv[i]; }
    asm volatile("s_waitcnt lgkmcnt(0)" ::: "memory");
    const int c = lane & 7;
#pragma unroll
    for (int j = 0; j < 4; ++j) { const int n = (lane >> 3) + 8 * j; const LAS float* s = scr + (8 * c) * 33 + n;
        u32x4 o; o.x = pk2(s[0 * 33], s[1 * 33]); o.y = pk2(s[2 * 33], s[3 * 33]); o.z = pk2(s[4 * 33], s[5 * 33]); o.w = pk2(s[6 * 33], s[7 * 33]);
        *(u32x4*)(WT + (size_t)(r0 + n) * K + k0 + 8 * c) = o; }
    asm volatile("s_waitcnt lgkmcnt(0)" ::: "memory");
}
__device__ __forceinline__ void p0_prologue(const Args& a, LAS unsigned char* lds, int gw, int NGW, int wave, int lane) {
    unsigned char* ws = a.ws;
    LAS float* scr = (LAS float*)(lds + wave * 16384);
    const float* w_in = a.in[2];
    int it = gw;
    for (;; it += NGW) {
        int r = it; const float* src; int ld, K, col0, ncols, row0, mode = 0; bf16* dst;
#define SEC(S, LD, KK, C0, NC, DST, R0, MODE) { const int n_ = ((KK) / 64) * (((NC) + 31) / 32); if (r < n_) { src = (S); ld = (LD); K = (KK); col0 = (C0); ncols = (NC); dst = (bf16*)(ws + (DST)); row0 = (R0); mode = (MODE); goto found; } r -= n_; }
        SEC(w_in, 7240, 1024, 0, 768, WS_WIN, 0, 0)
        SEC(w_in, 7240, 1024, 768, 768, WS_WIN, 768, 0)
        SEC(w_in, 7240, 1024, 1536, 768, WS_WV, 0, 0)
        SEC(w_in, 7240, 1024, 2304, 768, WS_WIN, 1536, 0)
        SEC(w_in, 7240, 1024, 3072, 768, WS_WIN, 2304, 0)
        SEC(w_in, 7240, 1024, 3840, 768, WS_WV, 768, 0)
        SEC(w_in, 7240, 1024, 4608, 512, WS_WIN, 3072, 0)
        SEC(w_in, 7240, 1024, 5120, 64, WS_WIN, 3584, 0)
        SEC(w_in, 7240, 1024, 5184, 8, WS_WIN, 3648, 0)
        SEC(w_in, 7240, 1024, 5192, 2048, WS_WGATE, 0, 0)
        SEC(a.in[4], 1024, 768, 0, 1024, WS_WA, 0, 0)
        SEC(a.in[5], 1024, 256, 0, 1024, WS_WB, 0, 0)
        SEC(a.in[6], 1024, 1024, 0, 1024, WS_WO, 0, 0)
        SEC(a.in[9], 2816, 1024, 0, 2816, WS_WGU, 0, 1)
        SEC(a.in[10], 2816, 1024, 0, 2816, WS_WGU, 128, 1)
        SEC(a.in[11], 1024, 2816, 0, 1024, WS_WD, 0, 0)
#undef SEC
        break;
    found:;
        const int nblk = (ncols + 31) / 32, kb = r / nblk, nb = r % nblk, n0 = 32 * nb;
        const int nvalid = (ncols - n0) < 32 ? (ncols - n0) : 32;
        const int r0 = row0 + (mode ? 256 * (n0 / 128) + (n0 % 128) : n0);
        tr_item(src, ld, K, col0 + n0, nvalid, dst, r0, 64 * kb, scr, lane);
    }
    { u32x4* p = (u32x4*)(ws + WS_WIN + (size_t)3680 * DM * 2); const int n16 = 160 * DM * 2 / 16;
      for (int i = gw * 64 + lane; i < n16; i += NGW * 64) p[i] = (u32x4){0u, 0u, 0u, 0u}; }
    { const f32x4* x4 = (const f32x4*)a.in[0]; u32x4* xb = (u32x4*)(ws + WS_XB); const int n8 = M * DM / 8; const int stride = NGW * 64;
      for (int i = gw * 64 + lane; i < n8; i += 4 * stride) { f32x4 p[4], q[4];
#pragma unroll
          for (int u = 0; u < 4; ++u) { const int ii = i + u * stride; if (ii < n8) { p[u] = x4[2 * ii]; q[u] = x4[2 * ii + 1]; } }
#pragma unroll
          for (int u = 0; u < 4; ++u) { const int ii = i + u * stride; if (ii < n8) { u32x4 o; o.x = pk2(p[u][0], p[u][1]); o.y = pk2(p[u][2], p[u][3]); o.z = pk2(q[u][0], q[u][1]); o.w = pk2(q[u][2], q[u][3]); xb[ii] = o; } } } }
    { const int* pos = (const int*)a.in[1]; float* cs = (float*)(ws + WS_CS);
      for (int i = gw * 64 + lane; i < M * 8; i += NGW * 64) { const int row = i >> 3, f = i & 7;
          const float inv = powf(500000.0f, -(float)(2 * f) / 16.0f); const float ang = (float)pos[row] * inv;
          cs[row * 16 + f] = cosf(ang); cs[row * 16 + 8 + f] = sinf(ang); } }
}

#define WRL(dst, sval, ln) asm volatile("s_nop 4\n\tv_writelane_b32 %0, %1, %2\n\ts_nop 1" : "+v"(dst) : "s"(sval), "i"(ln))
__device__ __forceinline__ void indexer_phase(LAS unsigned char* lds, const bf16* QI, const bf16* KIWI, u64* MASK, int blk, int nblk, int wid, int lane) {
    LAS float* sc = (LAS float*)lds;
    const int m = lane & 31, kh = lane >> 5;
    const int qloc = 2 * ((m >> 2) & 1) + ((m >> 4) & 1), head = 4 * ((m >> 3) & 1) + (m & 3);
    bf16x8 qf[2][4]; u32x4 wraw[2][2]; bf16x8 k0[4], k1[4], k2[4], k3[4];
#define LOADK(buf, KT) do { const int ktc_ = (KT) < nkt ? (KT) : nkt - 1; const bf16* kp_ = kbase + (size_t)ktc_ * 2048; _Pragma("unroll") for (int kk = 0; kk < 4; ++kk) buf[kk] = *(const bf16x8*)(kp_ + 512 * kk); } while (0)
#define LOAD_UNIT(U) do { const int b_ = (U) & 7, t0_ = ((U) >> 3) * 8; const size_t rb_ = (size_t)b_ * SEQ; \
        _Pragma("unroll") for (int r2 = 0; r2 < 2; ++r2) { const bf16* qp = QI + (rb_ + t0_ + 4 * r2 + qloc) * 512 + head * 64 + 8 * kh; \
            _Pragma("unroll") for (int kk = 0; kk < 4; ++kk) qf[r2][kk] = *(const bf16x8*)(qp + 16 * kk); \
            _Pragma("unroll") for (int i = 0; i < 2; ++i) wraw[r2][i] = *(const u32x4*)(KIWI + (size_t)2097152 + (rb_ + t0_ + 4 * r2 + 2 * kh + i) * 8); } \
        { const int nkt = (t0_ + 7) / 32 + 1; const bf16* kbase = KIWI + (rb_ / 32) * 2048 + (kh * 32 + m) * 8; LOADK(k0, wid); LOADK(k1, wid + 8); LOADK(k2, wid + 16); } } while (0)
    if (blk < BATCH * (SEQ / 8)) LOAD_UNIT(blk);
    for (int u = blk; u < BATCH * (SEQ / 8); u += nblk) {
        const int b = u & 7, t0 = (u >> 3) * 8;
        const size_t rb = (size_t)b * SEQ;
        {
            float wv[2][2][8];
#pragma unroll
            for (int r2 = 0; r2 < 2; ++r2)
#pragma unroll
                for (int i = 0; i < 2; ++i) { const u32x4 w = wraw[r2][i];
                    wv[r2][i][0] = bf_lo(w.x); wv[r2][i][1] = bf_hi(w.x); wv[r2][i][2] = bf_lo(w.y); wv[r2][i][3] = bf_hi(w.y); wv[r2][i][4] = bf_lo(w.z); wv[r2][i][5] = bf_hi(w.z); wv[r2][i][6] = bf_lo(w.w); wv[r2][i][7] = bf_hi(w.w); }
            const int nkt = (t0 + 7) / 32 + 1;
            const bf16* kbase = KIWI + (rb / 32) * 2048 + (kh * 32 + m) * 8;
#define COMPK(buf, KT) do { if ((KT) < nkt) { const int key = 32 * (KT) + m; \
                f32x16 a0 = {0, 0, 0, 0, 0, 0, 0, 0, 0, 0, 0, 0, 0, 0, 0, 0}, a1 = a0; \
                _Pragma("unroll") for (int kk = 0; kk < 4; ++kk) { a0 = __builtin_amdgcn_mfma_f32_32x32x16_bf16(qf[0][kk], buf[kk], a0, 0, 0, 0); a1 = __builtin_amdgcn_mfma_f32_32x32x16_bf16(qf[1][kk], buf[kk], a1, 0, 0, 0); } \
                _Pragma("unroll") for (int i = 0; i < 2; ++i) { float r0_[8], r1_[8]; \
                    _Pragma("unroll") for (int h = 0; h < 8; ++h) { r0_[h] = __builtin_amdgcn_fmed3f(a0[8 * i + h], 0.f, __builtin_inff()); r1_[h] = __builtin_amdgcn_fmed3f(a1[8 * i + h], 0.f, __builtin_inff()); } \
                    const float pa_ = fmaf(wv[0][i][1], r0_[1], wv[0][i][0] * r0_[0]), pb_ = fmaf(wv[0][i][3], r0_[3], wv[0][i][2] * r0_[2]), pc_ = fmaf(wv[0][i][5], r0_[5], wv[0][i][4] * r0_[4]), pd_ = fmaf(wv[0][i][7], r0_[7], wv[0][i][6] * r0_[6]); \
                    const float qa_ = fmaf(wv[1][i][1], r1_[1], wv[1][i][0] * r1_[0]), qb_ = fmaf(wv[1][i][3], r1_[3], wv[1][i][2] * r1_[2]), qc_ = fmaf(wv[1][i][5], r1_[5], wv[1][i][4] * r1_[4]), qd_ = fmaf(wv[1][i][7], r1_[7], wv[1][i][6] * r1_[6]); \
                    const float s0_ = (pa_ + pb_) + (pc_ + pd_), s1_ = (qa_ + qb_) + (qc_ + qd_); \
                    sc[(2 * kh + i) * SCP + key] = s0_ + 0.0f; sc[(4 + 2 * kh + i) * SCP + key] = s1_ + 0.0f; } } } while (0)
            int kt = wid;
            for (; kt < nkt; kt += 32) {
                LOADK(k3, kt + 24); COMPK(k0, kt);
                LOADK(k0, kt + 32); COMPK(k1, kt + 8);
                LOADK(k1, kt + 40); COMPK(k2, kt + 16);
                LOADK(k2, kt + 48); COMPK(k3, kt + 24);
            }
#undef COMPK
            if (u + nblk < BATCH * (SEQ / 8)) LOAD_UNIT(u + nblk);
        }
        __syncthreads();
        {
            const int t = t0 + wid, jmax = t >> 6;
            unsigned uv[64]; const int lim = t - lane;
#pragma unroll
            for (int j = 0; j < 64; ++j) { const unsigned bts = __float_as_uint(sc[wid * SCP + 64 * j + lane]);
                const unsigned s = bts ^ ((unsigned)((int)bts >> 31) | 0x80000000u); uv[j] = (64 * j <= lim) ? s : 0u; }
            unsigned mw_lo = 0u, mw_hi = 0u;
            u64 mm[8];
#define CMP8(OP, OFF, C) asm("v_cmp_" OP "_u32_e64 %0, %8, %16\n\tv_cmp_" OP "_u32_e64 %1, %9, %16\n\tv_cmp_" OP "_u32_e64 %2, %10, %16\n\tv_cmp_" OP "_u32_e64 %3, %11, %16\n\t" \
                "v_cmp_" OP "_u32_e64 %4, %12, %16\n\tv_cmp_" OP "_u32_e64 %5, %13, %16\n\tv_cmp_" OP "_u32_e64 %6, %14, %16\n\tv_cmp_" OP "_u32_e64 %7, %15, %16" \
                : "=&s"(mm[0]), "=&s"(mm[1]), "=&s"(mm[2]), "=&s"(mm[3]), "=&s"(mm[4]), "=&s"(mm[5]), "=&s"(mm[6]), "=&s"(mm[7]) \
                : "v"(uv[(OFF) + 0]), "v"(uv[(OFF) + 1]), "v"(uv[(OFF) + 2]), "v"(uv[(OFF) + 3]), "v"(uv[(OFF) + 4]), "v"(uv[(OFF) + 5]), "v"(uv[(OFF) + 6]), "v"(uv[(OFF) + 7]), "s"(C))
#define POP8() (__popcll(mm[0]) + __popcll(mm[1]) + __popcll(mm[2]) + __popcll(mm[3]) + __popcll(mm[4]) + __popcll(mm[5]) + __popcll(mm[6]) + __popcll(mm[7]))
#define WRL8(OFF) asm volatile("s_nop 4\n\tv_writelane_b32 %0, %2, %18\n\tv_writelane_b32 %1, %3, %18\n\tv_writelane_b32 %0, %4, %19\n\tv_writelane_b32 %1, %5, %19\n\t" \
                "v_writelane_b32 %0, %6, %20\n\tv_writelane_b32 %1, %7, %20\n\tv_writelane_b32 %0, %8, %21\n\tv_writelane_b32 %1, %9, %21\n\t" \
                "v_writelane_b32 %0, %10, %22\n\tv_writelane_b32 %1, %11, %22\n\tv_writelane_b32 %0, %12, %23\n\tv_writelane_b32 %1, %13, %23\n\t" \
                "v_writelane_b32 %0, %14, %24\n\tv_writelane_b32 %1, %15, %24\n\tv_writelane_b32 %0, %16, %25\n\tv_writelane_b32 %1, %17, %25\n\ts_nop 1" \
                : "+v"(mw_lo), "+v"(mw_hi) \
                : "s"((unsigned)mm[0]), "s"((unsigned)(mm[0] >> 32)), "s"((unsigned)mm[1]), "s"((unsigned)(mm[1] >> 32)), "s"((unsigned)mm[2]), "s"((unsigned)(mm[2] >> 32)), "s"((unsigned)mm[3]), "s"((unsigned)(mm[3] >> 32)), \
                  "s"((unsigned)mm[4]), "s"((unsigned)(mm[4] >> 32)), "s"((unsigned)mm[5]), "s"((unsigned)(mm[5] >> 32)), "s"((unsigned)mm[6]), "s"((unsigned)(mm[6] >> 32)), "s"((unsigned)mm[7]), "s"((unsigned)(mm[7] >> 32)), \
                  "i"((OFF) + 0), "i"((OFF) + 1), "i"((OFF) + 2), "i"((OFF) + 3), "i"((OFF) + 4), "i"((OFF) + 5), "i"((OFF) + 6), "i"((OFF) + 7))
            if (t < 256) {
#pragma unroll
                for (int j = 0; j < 4; ++j) { const u64 wd = __ballot(64 * j + lane <= t); WRL(mw_lo, (unsigned)wd, j); WRL(mw_hi, (unsigned)(wd >> 32), j); }
            } else {
                unsigned um = 0u;
#pragma unroll
                for (int j = 0; j < 64; ++j) um = uv[j] > um ? uv[j] : um;
#pragma unroll
                for (int o = 1; o < 64; o <<= 1) { const unsigned x = (unsigned)__shfl_xor((int)um, o); um = x > um ? x : um; }
                unsigned lo = 1u, hi = (unsigned)__builtin_amdgcn_readfirstlane(um) + 1u, ustar = 1u; int c_lo = t + 1, c_hi = 0, cge = 0; bool bis = false;
                for (;;) {
                    const unsigned width = hi - lo;
                    if (width <= 1u) { ustar = lo; cge = c_lo; break; }
                    unsigned step;
                    if (bis) step = width >> 1;
                    else { const float frac = ((float)(c_lo - 256) + 0.5f) / (float)(c_lo - c_hi); step = (unsigned)((float)width * frac); step = step < 1u ? 1u : step; step = step > width - 1u ? width - 1u : step; }
                    const unsigned cand = (unsigned)__builtin_amdgcn_readfirstlane(lo + step); int cnt = 0;
#pragma unroll
                    for (int g = 0; g < 8; ++g) if (8 * g <= jmax) { CMP8("ge", 8 * g, cand); cnt += POP8(); }
                    if (cnt == 256) { ustar = cand; cge = 256; break; }
                    if (cnt > 256) { lo = cand; c_lo = cnt; } else { hi = cand; c_hi = cnt; }
                    bis = (hi - lo) > (width >> 1);
                }
                ustar = __builtin_amdgcn_readfirstlane(ustar);
                if (cge == 256) {
#pragma unroll
                    for (int g = 0; g < 8; ++g) { CMP8("ge", 8 * g, ustar); WRL8(8 * g); }
                } else {
                    int cgt = 0;
#pragma unroll
                    for (int j = 0; j < 64; ++j) { cgt += __popcll(__ballot(uv[j] > ustar)); __builtin_amdgcn_sched_barrier(0); }
                    int remaining = 256 - cgt; asm volatile("" : "+s"(ustar));
#pragma unroll
                    for (int j = 0; j < 64; ++j) { const bool eq = uv[j] == ustar; const u64 em = __ballot(eq);
                        const int rank = __builtin_amdgcn_mbcnt_hi((unsigned)(em >> 32), __builtin_amdgcn_mbcnt_lo((unsigned)em, 0u));
                        const bool sel = (uv[j] > ustar) || (eq && rank < remaining); const int c = __popcll(em); remaining -= (c < remaining ? c : remaining);
                        const u64 wd = __ballot(sel); WRL(mw_lo, (unsigned)wd, j); WRL(mw_hi, (unsigned)(wd >> 32), j); __builtin_amdgcn_sched_barrier(0); }
                }
            }
#undef CMP8
#undef POP8
#undef WRL8
            MASK[((size_t)(b * 64 + lane)) * SEQ + t] = ((u64)mw_hi << 32) | (u64)mw_lo;
        }
        __syncthreads();
    }
}

__device__ __forceinline__ int pi32(int r) { return (r & 0x13) | ((r & 4) << 1) | ((r & 8) >> 1); }
__device__ __forceinline__ void attn_unit(LAS unsigned char* lds, const bf16* Q, const bf16* K, const bf16* VT, bf16* O, float* LSE, const u64* MASK,
                                          bool isB, int b, int h, int q0, int t_lo, int t_hi, int win, int dsh, int tid, int wid, int lane, bool dry = false) {
    const int ql = lane & 31, hi = lane >> 5;
    const size_t rb = (size_t)b * SEQ; const int tq = q0 + 32 * wid + ql; const size_t rowq = rb + tq;
    bf16x8 qf[4];
#pragma unroll
    for (int kk = 0; kk < 4; ++kk) qf[kk] = *(const bf16x8*)(Q + rowq * 768 + h * 64 + 16 * kk + 8 * hi);
    f32x16 o0 = {0, 0, 0, 0, 0, 0, 0, 0, 0, 0, 0, 0, 0, 0, 0, 0}, o1 = o0;
    float m_run = -1e30f, l_run = 0.f, f_pend = 1.f; bool pend = false;
    const int sr = tid >> 3, scc = tid & 7;
    const bf16* ksrc = K + (rb + sr) * 768 + h * 64 + 8 * scc;
    const bf16* vsrc = VT + (size_t)(h * 64 + sr) * M + rb + 8 * scc;
    const int swoff = (sr * 72 + 8 * scc) * 2;
    const int kroff = (pi32(ql) * 72 + 8 * hi) * 2, vroff = 9216 + (ql * 72 + 8 * hi) * 2;
    const u64* mrow = MASK + (isB ? (size_t)0 : (size_t)b * 64 * SEQ + tq); const size_t mstr = isB ? 0 : SEQ;
    const u64 pat = (dsh == 0 ? ~0ull : (dsh == 2 ? 0x1111111111111111ull : 0x0001000100010001ull)) << (tq & ((1 << dsh) - 1));
    const int t_last = t_hi - 1;
    u32x4 kreg = *(const u32x4*)(ksrc + (size_t)64 * t_lo * 768), vreg = *(const u32x4*)(vsrc + 64 * t_lo);
    const int t1 = (t_lo + 1 < t_hi) ? t_lo + 1 : t_last;
    u32x4 kreg2 = *(const u32x4*)(ksrc + (size_t)64 * t1 * 768), vreg2 = *(const u32x4*)(vsrc + 64 * t1);
    u64 mw_cur = mrow[(size_t)t_lo * mstr];
    __syncthreads();
    *(LAS u32x4*)(lds + swoff) = kreg; *(LAS u32x4*)(lds + 9216 + swoff) = vreg;
    *(LAS u32x4*)(lds + 18432 + swoff) = kreg2; *(LAS u32x4*)(lds + 18432 + 9216 + swoff) = vreg2;
    __syncthreads();
#define QKT(SB, S0, S1) do { S0 = (f32x16){0, 0, 0, 0, 0, 0, 0, 0, 0, 0, 0, 0, 0, 0, 0, 0}; S1 = S0; \
        _Pragma("unroll") for (int kk = 0; kk < 4; ++kk) { const bf16x8 a0_ = *(const LAS bf16x8*)(lds + (SB) + kroff + 32 * kk), a1_ = *(const LAS bf16x8*)(lds + (SB) + kroff + 32 * 144 + 32 * kk); \
            S0 = __builtin_amdgcn_mfma_f32_32x32x16_bf16(a0_, qf[kk], S0, 0, 0, 0); S1 = __builtin_amdgcn_mfma_f32_32x32x16_bf16(a1_, qf[kk], S1, 0, 0, 0); } } while (0)
#define PVM(SB) do { _Pragma("unroll") for (int s_ = 0; s_ < 2; ++s_) _Pragma("unroll") for (int k2 = 0; k2 < 2; ++k2) { const int co = (32 * s_ + 16 * k2) * 2; \
            const bf16x8 v0_ = *(const LAS bf16x8*)(lds + (SB) + vroff + co), v1_ = *(const LAS bf16x8*)(lds + (SB) + vroff + 32 * 144 + co); \
            o0 = __builtin_amdgcn_mfma_f32_32x32x16_bf16(v0_, pf[s_][k2], o0, 0, 0, 0); o1 = __builtin_amdgcn_mfma_f32_32x32x16_bf16(v1_, pf[s_][k2], o1, 0, 0, 0); } } while (0)
#define RESC() do { if (__any(pend)) { _Pragma("unroll") for (int j = 0; j < 16; ++j) { o0[j] *= f_pend; o1[j] *= f_pend; } } } while (0)
    f32x16 sA0, sA1, sB0, sB1;
    QKT(0, sA0, sA1);
    bf16x8 pf[2][2];
#pragma unroll
    for (int s_ = 0; s_ < 2; ++s_)
#pragma unroll
        for (int k2 = 0; k2 < 2; ++k2) pf[s_][k2] = (bf16x8){0, 0, 0, 0, 0, 0, 0, 0};
    int stm = 0, st0 = 0, st1 = 18432, st2 = 36864, st3 = 55296;
#define STEP(C0, C1, N0, N1, T, LK, LV, WK, WV) do { const int t_ = (T); \
        RESC(); \
        { const int tl_ = (t_ + 3 < t_hi) ? t_ + 3 : t_last; LK = *(const u32x4*)(ksrc + (size_t)64 * tl_ * 768); LV = *(const u32x4*)(vsrc + 64 * tl_); } \
        const u64 mw_nx = mrow[(size_t)((t_ + 1 < t_hi) ? t_ + 1 : t_last) * mstr]; \
        u64 mw; { const int hi_i = tq - 64 * t_, lo_i = hi_i - win; \
            const u64 up = hi_i >= 63 ? ~0ull : (hi_i < 0 ? 0ull : ((2ull << hi_i) - 1ull)); const u64 lw = lo_i <= 0 ? ~0ull : (lo_i > 63 ? 0ull : (~0ull << lo_i)); \
            mw = isB ? (pat & up & lw) : mw_cur; } \
        QKT(st1, N0, N1); \
        PVM(stm); \
        const unsigned m0 = (unsigned)(mw >> (8 * hi)), m1 = (unsigned)(mw >> (32 + 8 * hi)); \
        const unsigned NEGB = 0xF149F2CAu; float mt_[16]; \
        _Pragma("unroll") for (int j = 0; j < 16; ++j) { const int bp = (j & 7) + 16 * (j >> 3); \
            const unsigned k0_ = (unsigned)__builtin_amdgcn_sbfe((int)m0, bp, 1), k1_ = (unsigned)__builtin_amdgcn_sbfe((int)m1, bp, 1); \
            C0[j] = __uint_as_float((__float_as_uint(C0[j]) & k0_) | (NEGB & ~k0_)); C1[j] = __uint_as_float((__float_as_uint(C1[j]) & k1_) | (NEGB & ~k1_)); \
            mt_[j] = __builtin_amdgcn_fmed3f(C0[j], C1[j], __builtin_inff()); } \
        _Pragma("unroll") for (int w_ = 8; w_ >= 1; w_ >>= 1) _Pragma("unroll") for (int j = 0; j < w_; ++j) mt_[j] = __builtin_amdgcn_fmed3f(mt_[j], mt_[j + w_], __builtin_inff()); \
        float mx = mt_[0]; \
        { auto rr_ = __builtin_amdgcn_permlane32_swap(__float_as_uint(mx), __float_as_uint(mx), false, false); mx = __builtin_amdgcn_fmed3f(__uint_as_float(rr_[0]), __uint_as_float(rr_[1]), __builtin_inff()); } \
        { const float mn = fmaxf(m_run, mx); pend = mn > m_run; f_pend = __builtin_amdgcn_exp2f(m_run - mn); m_run = mn; l_run *= f_pend; } \
        float pt_[16]; \
        _Pragma("unroll") for (int j = 0; j < 16; ++j) { C0[j] = __builtin_amdgcn_exp2f(C0[j] - m_run); C1[j] = __builtin_amdgcn_exp2f(C1[j] - m_run); pt_[j] = C0[j] + C1[j]; } \
        _Pragma("unroll") for (int w_ = 8; w_ >= 1; w_ >>= 1) _Pragma("unroll") for (int j = 0; j < w_; ++j) pt_[j] += pt_[j + w_]; \
        const float ps = pt_[0]; \
        l_run += ps; \
        _Pragma("unroll") for (int k2 = 0; k2 < 2; ++k2) { u32x4 w0, w1; \
            w0.x = pg8::cvt_pk_bf16(C0[8 * k2 + 0], C0[8 * k2 + 1]); w0.y = pg8::cvt_pk_bf16(C0[8 * k2 + 2], C0[8 * k2 + 3]); w0.z = pg8::cvt_pk_bf16(C0[8 * k2 + 4], C0[8 * k2 + 5]); w0.w = pg8::cvt_pk_bf16(C0[8 * k2 + 6], C0[8 * k2 + 7]); \
            w1.x = pg8::cvt_pk_bf16(C1[8 * k2 + 0], C1[8 * k2 + 1]); w1.y = pg8::cvt_pk_bf16(C1[8 * k2 + 2], C1[8 * k2 + 3]); w1.z = pg8::cvt_pk_bf16(C1[8 * k2 + 4], C1[8 * k2 + 5]); w1.w = pg8::cvt_pk_bf16(C1[8 * k2 + 6], C1[8 * k2 + 7]); \
            pf[0][k2] = __builtin_bit_cast(bf16x8, w0); pf[1][k2] = __builtin_bit_cast(bf16x8, w1); } \
        _Pragma("unroll") for (int g_ = 0; g_ < 16; ++g_) { __builtin_amdgcn_sched_group_barrier(0x008, 1, 0); __builtin_amdgcn_sched_group_barrier(0x002, 12, 0); } \
        *(LAS u32x4*)(lds + st2 + swoff) = WK; *(LAS u32x4*)(lds + st2 + 9216 + swoff) = WV; \
        __syncthreads(); \
        mw_cur = mw_nx; { const int r_ = (stm == st0) ? st3 : stm; stm = st0; st0 = st1; st1 = st2; st2 = r_; } } while (0)
    int t = t_lo;
    { const int tl_ = (t_lo + 2 < t_hi) ? t_lo + 2 : t_last; kreg2 = *(const u32x4*)(ksrc + (size_t)64 * tl_ * 768); vreg2 = *(const u32x4*)(vsrc + 64 * tl_); }
    for (; t + 1 < t_hi; t += 2) { STEP(sA0, sA1, sB0, sB1, t, kreg, vreg, kreg2, vreg2); STEP(sB0, sB1, sA0, sA1, t + 1, kreg2, vreg2, kreg, vreg); }
    if (t < t_hi) STEP(sA0, sA1, sB0, sB1, t, kreg, vreg, kreg2, vreg2);
    RESC();
    PVM(stm);
#undef STEP
#undef QKT
#undef PVM
#undef RESC
    const float lt = l_run + __shfl_xor(l_run, 32); const float inv = 1.0f / lt;
    if (dry && lt > -1.f) return;
    bf16* op = O + rowq * 768 + h * 64 + 4 * hi;
#pragma unroll
    for (int jg = 0; jg < 4; ++jg) { u32x2 w;
        w.x = pk2(o0[4 * jg] * inv, o0[4 * jg + 1] * inv); w.y = pk2(o0[4 * jg + 2] * inv, o0[4 * jg + 3] * inv); *(u32x2*)(op + 8 * jg) = w;
        w.x = pk2(o1[4 * jg] * inv, o1[4 * jg + 1] * inv); w.y = pk2(o1[4 * jg + 2] * inv, o1[4 * jg + 3] * inv); *(u32x2*)(op + 32 + 8 * jg) = w; }
    if (isB && hi == 0) LSE[rowq * 12 + h] = 0.6931471805599453f * (m_run + log2f(lt));
}
__device__ __forceinline__ void attn_phase(LAS unsigned char* lds, unsigned char* ws, unsigned* ctr, int tid, int wid, int lane, bool dry = false) {
    LAS int* slot = (LAS int*)(lds + 77824);
    for (;;) {
        __syncthreads();
        if (tid == 0) *slot = (int)atomicAdd(ctr, 1u);
        __syncthreads();
        const int k = *slot;
        if (k >= 3072) break;
        if (k < 1536) { const int qb = 15 - k / 96, rem = k % 96, b = rem / 12, h = rem % 12;
            attn_unit(lds, (const bf16*)(ws + WS_QA), (const bf16*)(ws + WS_KA), (const bf16*)(ws + WS_VAT), (bf16*)(ws + WS_QA), nullptr, (const u64*)(ws + WS_MASK),
                      false, b, h, 256 * qb, 0, 4 * qb + 4, 0, 0, tid, wid, lane, dry);
        } else { const int k2 = k - 1536, gs = 2 - k2 / 512, r = k2 % 512, qb = 15 - r / 32, rem = r % 32, b = rem / 4, hg = rem % 4;
            const int win = gs == 0 ? 128 : (gs == 1 ? 512 : 2048), dsh = gs == 0 ? 0 : (gs == 1 ? 2 : 4);
            const int q0 = 256 * qb; const int lo = q0 - win; const int t_lo = lo > 0 ? lo / 64 : 0;
            attn_unit(lds, (const bf16*)(ws + WS_QB), (const bf16*)(ws + WS_KB), (const bf16*)(ws + WS_VBT), (bf16*)(ws + WS_QB), (float*)(ws + WS_LSE), nullptr,
                      true, b, gs * 4 + hg, q0, t_lo, 4 * qb + 4, win, dsh, tid, wid, lane, dry);
        }
    }
}

__device__ __forceinline__ void combine_b(unsigned char* ws, int gw, int NGW, int lane) {
    const bf16* OB = (const bf16*)(ws + WS_QB); const float* LSE = (const float*)(ws + WS_LSE); bf16* OBC = (bf16*)(ws + WS_OBC);
    for (int row = gw; row < M; row += NGW) { const int hg = lane >> 4, c = (lane & 15) * 4;
        const float l0 = LSE[(size_t)row * 12 + hg], l1 = LSE[(size_t)row * 12 + 4 + hg], l2 = LSE[(size_t)row * 12 + 8 + hg];
        const float mx = fmaxf(l0, fmaxf(l1, l2)); const float e0 = __expf(l0 - mx), e1 = __expf(l1 - mx), e2 = __expf(l2 - mx); const float inv = 1.f / (e0 + e1 + e2);
        const u32x2 a = *(const u32x2*)(OB + (size_t)row * 768 + hg * 64 + c), bb = *(const u32x2*)(OB + (size_t)row * 768 + 256 + hg * 64 + c), cc = *(const u32x2*)(OB + (size_t)row * 768 + 512 + hg * 64 + c);
        const float a0 = e0 * inv, a1 = e1 * inv, a2 = e2 * inv; u32x2 o;
        o.x = pk2(a0 * bf_lo(a.x) + a1 * bf_lo(bb.x) + a2 * bf_lo(cc.x), a0 * bf_hi(a.x) + a1 * bf_hi(bb.x) + a2 * bf_hi(cc.x));
        o.y = pk2(a0 * bf_lo(a.y) + a1 * bf_lo(bb.y) + a2 * bf_lo(cc.y), a0 * bf_hi(a.y) + a1 * bf_hi(bb.y) + a2 * bf_hi(cc.y));
        *(u32x2*)(OBC + (size_t)row * 256 + hg * 64 + c) = o; }
}
__device__ __forceinline__ void ln_rows(float* Z, const float* g, const float* bta, bf16* OB16, int gw, int NGW, int lane) {
    f32x4 gv[4], bv[4];
#pragma unroll
    for (int j = 0; j < 4; ++j) { gv[j] = ((const f32x4*)g)[lane + 64 * j]; bv[j] = ((const f32x4*)bta)[lane + 64 * j]; }
    for (int row0 = gw; row0 < M; row0 += 2 * NGW) {
        f32x4 v[2][4]; float s[2] = {0.f, 0.f}; f32x4* zr[2];
#pragma unroll
        for (int r = 0; r < 2; ++r) { const int row = row0 + r * NGW; zr[r] = (f32x4*)(Z + (size_t)(row < M ? row : row0) * DM) + lane;
#pragma unroll
            for (int j = 0; j < 4; ++j) v[r][j] = zr[r][64 * j]; }
#pragma unroll
        for (int r = 0; r < 2; ++r) {
#pragma unroll
            for (int j = 0; j < 4; ++j) s[r] += (v[r][j][0] + v[r][j][1]) + (v[r][j][2] + v[r][j][3]); }
        const float mean0 = wave_sum(s[0]) * (1.f / DM), mean1 = wave_sum(s[1]) * (1.f / DM); float s2[2] = {0.f, 0.f};
#pragma unroll
        for (int r = 0; r < 2; ++r) { const float mean = r ? mean1 : mean0;
#pragma unroll
            for (int j = 0; j < 4; ++j) { v[r][j] = v[r][j] - mean; s2[r] += (v[r][j][0] * v[r][j][0] + v[r][j][1] * v[r][j][1]) + (v[r][j][2] * v[r][j][2] + v[r][j][3] * v[r][j][3]); } }
        const float rs0 = 1.f / sqrtf(wave_sum(s2[0]) * (1.f / DM) + 1e-5f), rs1 = 1.f / sqrtf(wave_sum(s2[1]) * (1.f / DM) + 1e-5f);
#pragma unroll
        for (int r = 0; r < 2; ++r) { const int row = row0 + r * NGW; if (row < M) { const float rstd = r ? rs1 : rs0;
#pragma unroll
            for (int j = 0; j < 4; ++j) { const f32x4 y = v[r][j] * rstd * gv[j] + bv[j]; zr[r][64 * j] = y;
                if (OB16) { u32x2 w; w.x = pk2(y[0], y[1]); w.y = pk2(y[2], y[3]); *((u32x2*)(OB16 + (size_t)row * DM) + lane + 64 * j) = w; } } } }
    }
}

#define XB_TMO      128
#define XB_XCNT(j)  (256  + 64 * (j))
#define XB_XSUB(j)  (1280 + 64 * (j))
#define XB_XGEN(j)  (2304 + 64 * (j))
#define XB_TOP      3328
#define XB_TOPGEN   3392
#define XCD_BAR_WORDS 3456
#define XB_SPIN_CAP (1u << 18)

__device__ __forceinline__ unsigned xb_ld(unsigned* p)              { return __hip_atomic_load(p, __ATOMIC_RELAXED, __HIP_MEMORY_SCOPE_AGENT); }
__device__ __forceinline__ unsigned xb_add(unsigned* p, unsigned v) { return __hip_atomic_fetch_add(p, v, __ATOMIC_RELAXED, __HIP_MEMORY_SCOPE_AGENT); }
__device__ __forceinline__ unsigned xb_xcc_id() { return (unsigned)__builtin_amdgcn_s_getreg((3 << 11) | 20) & 0xFu; }
#define XB_SPIN(cond, bar) do { unsigned _sp = 0; while (cond) { __builtin_amdgcn_s_sleep(1); \
    if ((++_sp & 255u) == 0u) { if (xb_ld(&(bar)[XB_TMO])) break; if (_sp > XB_SPIN_CAP) { atomicAdd(&(bar)[XB_TMO], 1u); break; } } } } while (0)

struct XcdBarrier {
    unsigned* bar; unsigned x;
    volatile LAS unsigned* st;
};

__device__ __forceinline__ XcdBarrier xcd_barrier_post(unsigned* bar, volatile LAS unsigned* st) {
    XcdBarrier b; b.bar = bar; b.x = xb_xcc_id(); b.st = st;
    if (threadIdx.x == 0) (void)xb_add(&bar[XB_XCNT(b.x)], 1u);
    return b;
}
__device__ __forceinline__ void xcd_barrier_complete(unsigned* bar, unsigned x, unsigned& nloc, unsigned& nx) {
    const unsigned G = gridDim.x * gridDim.y * gridDim.z;
    unsigned sum, cnt, mine, sp = 0u;
    for (;;) {
        sum = 0u; cnt = 0u; mine = 0u;
#pragma unroll
        for (unsigned j = 0; j < 16; ++j) { const unsigned c = xb_ld(&bar[XB_XCNT(j)]); sum += c; cnt += (c > 0u) ? 1u : 0u; mine = (j == x) ? c : mine; }
        if (sum == G) break;
        __builtin_amdgcn_s_sleep(1);
        if ((++sp & 255u) == 0u) { if (xb_ld(&bar[XB_TMO])) break; if (sp > XB_SPIN_CAP) { atomicAdd(&bar[XB_TMO], 1u); break; } }
    }
    nloc = mine > 0u ? mine : 1u; nx = cnt > 0u ? cnt : 1u;
}

__device__ __forceinline__ void xcd_barrier(const XcdBarrier& b) {
    asm volatile("s_waitcnt vmcnt(0)" ::: "memory");
    __syncthreads();
    if (threadIdx.x == 0) {
        unsigned* bar = b.bar;
        __builtin_amdgcn_s_waitcnt(0);
        unsigned nloc = b.st[0], nx = b.st[1];
        if (nloc == 0u) { xcd_barrier_complete(bar, b.x, nloc, nx); b.st[0] = nloc; b.st[1] = nx; }
        const unsigned old = xb_add(&bar[XB_XSUB(b.x)], 1u);
        const unsigned gen = old / nloc;
        if (old + 1u == (gen + 1u) * nloc) {
            __builtin_amdgcn_fence(__ATOMIC_RELEASE, "agent");
            asm volatile("s_waitcnt vmcnt(0)" ::: "memory");
            const unsigned og = xb_add(&bar[XB_TOP], 1u);
            const unsigned tg = og / nx;
            if (og + 1u == (tg + 1u) * nx) xb_add(&bar[XB_TOPGEN], 1u);
            else XB_SPIN(xb_ld(&bar[XB_TOPGEN]) == tg, bar);
            __builtin_amdgcn_fence(__ATOMIC_ACQUIRE, "agent");
            xb_add(&bar[XB_XGEN(b.x)], 1u);
            asm volatile("s_waitcnt vmcnt(0)" ::: "memory");
        } else {
            XB_SPIN(xb_ld(&bar[XB_XGEN(b.x)]) == gen, bar);
            __builtin_amdgcn_fence(__ATOMIC_ACQUIRE, "agent");
            asm volatile("s_waitcnt vmcnt(0)" ::: "memory");
        }
    }
    __syncthreads();
}

__global__ void __launch_bounds__(NTHR, 2) fwd_megakernel(Args args) {
    extern __shared__ __attribute__((aligned(16))) unsigned char lds_raw[];
    LAS unsigned char* lds = (LAS unsigned char*)lds_raw;
    const int tid = threadIdx.x, lane = tid & 63, wid = __builtin_amdgcn_readfirstlane(tid >> 6);
    const int G = gridDim.x, blk = blockIdx.x, gw = blk * NWAVES + wid, NGW = G * NWAVES;
    unsigned char* ws = args.ws;
    const int lo = args.ph_lo, hi = args.ph_hi;
    volatile LAS unsigned* xst = (volatile LAS unsigned*)(lds + LDS_BYTES - 16);
    if (tid < 4) xst[tid] = 0u;
    __syncthreads();
    XcdBarrier xbar = xcd_barrier_post((unsigned*)(ws + WS_CTL) + 4096, xst);
#ifndef PH_MASK
#define PH_MASK 0xFFFF
#endif
#define IN(k) (((PH_MASK >> (k)) & 1) && lo <= (k) && (k) < hi)
#define SEAM(k) do { if (IN(k) && IN((k) + 1)) { if ((k) == 0) cg::this_grid().sync(); else xcd_barrier(xbar); } } while (0)
    using namespace pg8;
    if (IN(0)) { p0_prologue(args, lds, gw, NGW, wid, lane); }
    SEAM(0);
    if (IN(1)) {
        { Gemm g{(const bf16_t*)(ws + WS_XB), (const bf16_t*)(ws + WS_WIN), M, NPROJ, DM}; StaticOrder S; S.init(M, NPROJ, G, blk);
          EpiProj E{(bf16_t*)(ws + WS_QA), (bf16_t*)(ws + WS_KA), (bf16_t*)(ws + WS_QB), (bf16_t*)(ws + WS_KB), (bf16_t*)(ws + WS_QI), (bf16_t*)(ws + WS_KIWI), (const float*)(ws + WS_CS)};
          gemm_phase<EpiProj, StaticOrder, true, true>(lds, g, S, E); }
        { Gemm g{(const bf16_t*)(ws + WS_WV), (const bf16_t*)(ws + WS_XB), NVT, M, DM}; StaticOrder S; S.init(NVT, M, G, blk);
          EpiBf16 E{(bf16_t*)(ws + WS_VAT), (bf16_t*)(ws + WS_VBT), M};
          gemm_phase<EpiBf16, StaticOrder, true, true>(lds, g, S, E); }
    }
    SEAM(1);
    if (IN(2)) indexer_phase(lds, (const bf16*)(ws + WS_QI), (const bf16*)(ws + WS_KIWI), (u64*)(ws + WS_MASK), blk, G, wid, lane);
    SEAM(2);
#ifdef PROBE_ATT
    if (IN(3)) { attn_phase(lds, ws, (unsigned*)(ws + WS_CTL) + 128, tid, wid, lane, true); cg::this_grid().sync(); }
#endif
#ifdef PROBE_IDX
    if (IN(3)) { indexer_phase(lds, (const bf16*)(ws + WS_QI), (const bf16*)(ws + WS_KIWI), (u64*)(ws + WS_MASK), blk, G, wid, lane); cg::this_grid().sync(); }
#endif
    if (IN(3)) attn_phase(lds, ws, (unsigned*)(ws + WS_CTL) + 64, tid, wid, lane);
    SEAM(3);
    if (IN(4)) {
        combine_b(ws, gw, NGW, lane);
        Gemm g{(const bf16_t*)(ws + WS_XB), (const bf16_t*)(ws + WS_WGATE), M, NGATE, DM}; StaticOrder S; S.init(M, NGATE, G, blk);
        EpiGate E{(bf16_t*)(ws + WS_GATE), NGATE, args.in[3]};
        gemm_phase<EpiGate, StaticOrder, true, true>(lds, g, S, E);
    }
    SEAM(4);
    if (IN(5)) {
        { Gemm g{(const bf16_t*)(ws + WS_QA), (const bf16_t*)(ws + WS_WA), M, DM, 768}; StaticOrder S; S.init(M, DM, G, blk);
          EpiBrA E{args.out, (const bf16_t*)(ws + WS_GATE)};
          gemm_phase<EpiBrA, StaticOrder, true, true>(lds, g, S, E); }
        { Gemm g{(const bf16_t*)(ws + WS_OBC), (const bf16_t*)(ws + WS_WB), M, DM, 256}; StaticOrder S; S.init(M, DM, G, blk);
          EpiBrB E{args.out, (const bf16_t*)(ws + WS_GATE), (bf16_t*)(ws + WS_MIXED)};
          gemm_phase<EpiBrB, StaticOrder, true, true>(lds, g, S, E); }
    }
    SEAM(5);
    if (IN(6)) {
        Gemm g{(const bf16_t*)(ws + WS_MIXED), (const bf16_t*)(ws + WS_WO), M, DM, DM}; StaticOrder S; S.init(M, DM, G, blk);
        EpiRes E{args.in[0], args.out};
        gemm_phase<EpiRes, StaticOrder, true, true>(lds, g, S, E);
    }
    SEAM(6);
    if (IN(7)) ln_rows(args.out, args.in[7], args.in[8], (bf16*)(ws + WS_X1B), gw, NGW, lane);
    SEAM(7);
    if (IN(8)) {
        Gemm g{(const bf16_t*)(ws + WS_X1B), (const bf16_t*)(ws + WS_WGU), M, NGU, DM}; StaticOrder S; S.init(M, NGU, G, blk);
        EpiSwiGLU E{(bf16_t*)(ws + WS_H)};
        gemm_phase<EpiSwiGLU, StaticOrder, true, true>(lds, g, S, E);
    }
    SEAM(8);
    if (IN(9)) {
        Gemm g{(const bf16_t*)(ws + WS_H), (const bf16_t*)(ws + WS_WD), M, DM, FFN}; StaticOrder S; S.init(M, DM, G, blk);
        EpiRes E{args.out, args.out};
        gemm_phase<EpiRes, StaticOrder, true, true>(lds, g, S, E);
    }
    SEAM(9);
    if (IN(10)) ln_rows(args.out, args.in[12], args.in[13], nullptr, gw, NGW, lane);
#undef IN
#undef SEAM
}

constexpr int NPHASE = 11;
extern "C" void kernel_launch(void* const* d_in, const int* in_sizes, int n_in, void* d_out, int out_size, void* d_ws, size_t ws_size, hipStream_t stream) {
    static int grid = 0;
    if (grid == 0) {
        if (n_in != 14 || in_sizes[0] != M * DM || out_size != M * DM || ws_size < WS_END) { fprintf(stderr, "kernel_launch: unexpected shapes / workspace (n_in %d, ws %zu); nothing launched\n", n_in, ws_size); grid = -1; return; }
        int dev = 0, cus = 0, per_cu = 0;
        if (hipGetDevice(&dev) != hipSuccess || hipDeviceGetAttribute(&cus, hipDeviceAttributeMultiprocessorCount, dev) != hipSuccess) { grid = -1; return; }
        if (hipFuncSetAttribute((const void*)fwd_megakernel, hipFuncAttributeMaxDynamicSharedMemorySize, LDS_BYTES) != hipSuccess) { fprintf(stderr, "kernel_launch: hipFuncSetAttribute failed\n"); grid = -1; return; }
        if (hipOccupancyMaxActiveBlocksPerMultiprocessor(&per_cu, (const void*)fwd_megakernel, NTHR, LDS_BYTES) != hipSuccess || per_cu < 1) { fprintf(stderr, "kernel_launch: occupancy query says %d\n", per_cu); per_cu = 1; }
        (void)hipGetLastError();
        grid = cus * per_cu;
    }
    if (grid < 0) return;
    (void)hipMemsetAsync((char*)d_ws + WS_CTL, 0, 65536, stream);
    Args a{};
    for (int i = 0; i < 14; ++i) a.in[i] = (const float*)d_in[i];
    a.out = (float*)d_out; a.ws = (unsigned char*)d_ws;
#if MK_N_LAUNCHES == 1
    a.ph_lo = 0; a.ph_hi = NPHASE;
    void* kargs[] = {&a};
    hipError_t e = hipLaunchCooperativeKernel((const void*)fwd_megakernel, dim3(grid), dim3(NTHR), kargs, LDS_BYTES, stream);
    if (e != hipSuccess) fprintf(stderr, "cooperative launch failed: %s (grid %d)\n", hipGetErrorString(e), grid);
#else
    for (int p = 0; p < NPHASE; ++p) { a.ph_lo = p; a.ph_hi = p + 1; hipLaunchKernelGGL(fwd_megakernel, dim3(grid), dim3(NTHR), LDS_BYTES, stream, a); }
#endif
}
```
